# Optimizing an MI355X kernel written in HIP

```python
import math
import jax, jax.numpy as jnp
from jax import lax
import numpy as np

D_MODEL = 1024
BATCH = 8
SEQ = 4096
DEPTH = 2

GRID_W = 64
CTX_LEN = 256
N_MOD = 6
NORM_EPS = 1e-6
ROPE_THETA = 10000.0
Q_BLOCK = 128

HY_W = 256
HY_ORDER = 2
HY_BANDS = 16
HY_EMB = 1 + 2 * HY_BANDS
HY_FILT = 64
HY_CONV = 3
HY_TARGET = 1e-2
HY_FAST_PCT = 0.3
HY_SLOW_PCT = 1.5

GQA_HEADS = 6
GQA_KV_HEADS = 2
GQA_HEAD_DIM = 64

MLA_HEADS = 6
MLA_Q_RANK = 256
MLA_KV_RANK = 128
MLA_NOPE_DIM = 64
MLA_ROPE_DIM = 32
MLA_V_DIM = 64
MLA_QK_DIM = MLA_NOPE_DIM + MLA_ROPE_DIM

MIX_WIDTH = HY_W + GQA_HEADS * GQA_HEAD_DIM + MLA_HEADS * MLA_V_DIM
IN_SPLITS = (HY_W * (HY_ORDER + 1), GQA_HEADS * GQA_HEAD_DIM, GQA_KV_HEADS * GQA_HEAD_DIM,
             GQA_KV_HEADS * GQA_HEAD_DIM, MLA_Q_RANK, MLA_KV_RANK, MLA_ROPE_DIM)
IN_WIDTH = 1824
FFN_HIDDEN = ((8 * D_MODEL + 3 * 256 - 1) // (3 * 256)) * 256

kernel_name = "hybrid_hyena_gqa_mla_dit_block"


def rmsnorm(x, g):
    x32 = x.astype(jnp.float32)
    y = x32 * lax.rsqrt(jnp.mean(x32 * x32, axis=-1, keepdims=True) + NORM_EPS)
    return (y * g.astype(jnp.float32)).astype(x.dtype)


def split_cols(u, sizes):
    return jnp.split(u, np.cumsum(sizes)[:-1].tolist(), axis=-1)


def short_conv(u, w, b):
    up = jnp.pad(u, ((0, 0), (1, 1), (0, 0)))
    return up[:, :-2] * w[0] + up[:, 1:-1] * w[1] + up[:, 2:] * w[2] + b


def hyena_kernels(L, w1, b1, w2, b2, w3, freq):
    t = jnp.linspace(0.0, 1.0, L, dtype=jnp.float32)[:, None]
    wpos = 2.0 * math.pi * jnp.arange(L, dtype=jnp.float32)[:, None] / L
    f = jnp.linspace(1e-4, HY_BANDS - 1, HY_BANDS, dtype=jnp.float32)[None, :]
    z = jnp.concatenate([t, jnp.cos(f * wpos), -jnp.sin(f * wpos)], axis=-1)
    h = jnp.sin(freq * (z @ w1 + b1))
    h = jnp.sin(freq * (h @ w2 + b2))
    h = (h @ w3).astype(jnp.float32).reshape(L, HY_ORDER, 2, HY_W)
    deltas = jnp.abs(jnp.linspace(math.log(HY_TARGET) / HY_FAST_PCT, math.log(HY_TARGET) / HY_SLOW_PCT,
                                  HY_W, dtype=jnp.float32))
    h = h * jnp.exp(-t * deltas)[:, None, None, :]
    fwd, bwd = h[:, :, 0], h[:, :, 1]
    k = jnp.concatenate([fwd, jnp.zeros_like(fwd[:1]), bwd[:0:-1]], axis=0)
    return k / jnp.sum(jnp.abs(k), axis=0, keepdims=True)


def long_conv(z, k, bias):
    L = z.shape[1]
    z32 = z.astype(jnp.float32)
    Z = jnp.fft.rfft(z32, n=2 * L, axis=1)
    K = jnp.fft.rfft(k, n=2 * L, axis=0)
    y = jnp.fft.irfft(Z * K[None], n=2 * L, axis=1)[:, :L]
    return (y + z32 * bias.astype(jnp.float32)).astype(z.dtype)


def hyena_mixer(u, lp):
    L = u.shape[1]
    u = short_conv(u, lp["hy_conv_w"], lp["hy_conv_b"])
    v, x1, x2 = jnp.split(u, 3, axis=-1)
    k = hyena_kernels(L, lp["hy_filt_w1"], lp["hy_filt_b1"], lp["hy_filt_w2"], lp["hy_filt_b2"],
                      lp["hy_filt_w3"], lp["hy_filt_freq"])
    z = x1 * long_conv(v, k[:, 0], lp["hy_bias"][0])
    return x2 * long_conv(z, k[:, 1], lp["hy_bias"][1])


def _rope_1d(x, pos):
    d = x.shape[-1]
    inv = ROPE_THETA ** (-jnp.arange(0, d, 2, dtype=jnp.float32) / d)
    ang = pos.astype(jnp.float32)[:, None] * inv[None, :]
    ang = jnp.concatenate([ang, ang], axis=-1)[None, :, None, :]
    x32 = x.astype(jnp.float32)
    x1, x2 = jnp.split(x32, 2, axis=-1)
    rot = jnp.concatenate([-x2, x1], axis=-1)
    return (x32 * jnp.cos(ang) + rot * jnp.sin(ang)).astype(x.dtype)


def rope_2d(x, row, col):
    xr, xc = jnp.split(x, 2, axis=-1)
    return jnp.concatenate([_rope_1d(xr, row), _rope_1d(xc, col)], axis=-1)


def attn_queries(gq, mq, lp, row, col):
    B, L, _ = gq.shape
    qg = rmsnorm(gq.reshape(B, L, GQA_HEADS, GQA_HEAD_DIM), lp["gqa_q_g"])
    qm = (rmsnorm(mq, lp["mla_q_g"]) @ lp["mla_w_uq"]).reshape(B, L, MLA_HEADS, MLA_QK_DIM)
    qm_nope, qm_pe = jnp.split(qm, [MLA_NOPE_DIM], axis=-1)
    if row is not None:
        qg = rope_2d(qg, row, col)
        qm_pe = rope_2d(qm_pe, row, col)
    qm = jnp.concatenate([qm_nope, qm_pe], axis=-1)
    qg = qg.reshape(B, L, GQA_KV_HEADS, GQA_HEADS // GQA_KV_HEADS, GQA_HEAD_DIM)
    return qg, qm[:, :, :, None, :]


def attn_keys_values(gk, gv, mkv, mkr, lp, row, col):
    B, L, _ = gk.shape
    kg = rmsnorm(gk.reshape(B, L, GQA_KV_HEADS, GQA_HEAD_DIM), lp["gqa_k_g"])
    vg = gv.reshape(B, L, GQA_KV_HEADS, GQA_HEAD_DIM)
    kv = (rmsnorm(mkv, lp["mla_kv_g"]) @ lp["mla_w_ukv"]).reshape(B, L, MLA_HEADS, MLA_NOPE_DIM + MLA_V_DIM)
    km_nope, vm = jnp.split(kv, [MLA_NOPE_DIM], axis=-1)
    km_pe = mkr[:, :, None, :]
    if row is not None:
        kg = rope_2d(kg, row, col)
        km_pe = rope_2d(km_pe, row, col)
    km = jnp.concatenate([km_nope, jnp.broadcast_to(km_pe, (B, L, MLA_HEADS, MLA_ROPE_DIM))], axis=-1)
    return kg, vg, km, vm


def blocked_attention(q, k, v, scale):
    B, L, KH, G, Dq = q.shape
    nb = L // Q_BLOCK
    qb = jnp.moveaxis(q.reshape(B, nb, Q_BLOCK, KH, G, Dq), 1, 0)
    k32 = k.astype(jnp.float32)
    v32 = v.astype(jnp.float32)

    def one_block(qblk):
        s = jnp.einsum("bqkgd,bskd->bkgqs", qblk.astype(jnp.float32), k32) * scale
        p = jax.nn.softmax(s, axis=-1)
        return jnp.einsum("bkgqs,bskd->bqkgd", p, v32).astype(v.dtype)

    o = lax.map(one_block, qb)
    return jnp.moveaxis(o, 0, 1).reshape(B, L, KH * G * v.shape[-1])


def attend(q, kv):
    qg, qm = q
    kg, vg, km, vm = kv
    yg = blocked_attention(qg, kg, vg, GQA_HEAD_DIM ** -0.5)
    ym = blocked_attention(qm, km, vm, MLA_QK_DIM ** -0.5)
    return yg, ym


def merge_heads(y_hy, y_att, w_out):
    return jnp.concatenate([y_hy, y_att[0], y_att[1]], axis=-1) @ w_out


def swiglu(h, w1, w3, w2):
    return (jax.nn.silu(h @ w1) * (h @ w3)) @ w2


def setup_inputs(seed: int = 0) -> dict:
    key = jax.random.key(seed)
    ks = iter(jax.random.split(key, 32))

    def nrm(shape, scale):
        return jax.random.normal(next(ks), shape, jnp.float32) * scale

    def gain(shape):
        return 1.0 + nrm(shape, 0.05)

    D = D_MODEL
    return {
        "x": nrm((BATCH, SEQ, D), 1.0),
        "c": nrm((BATCH, D), 1.0),
        "ctx": nrm((BATCH, CTX_LEN, D), 1.0),
        "c_ctx": nrm((D,), 1.0),
        "mod_w": nrm((DEPTH, D, N_MOD * D), 0.5 * D ** -0.5),
        "mod_b": nrm((DEPTH, N_MOD * D), 0.01),
        "norm1_g": gain((DEPTH, D)),
        "norm2_g": gain((DEPTH, D)),
        "w_in": nrm((DEPTH, D, IN_WIDTH), D ** -0.5),
        "hy_conv_w": nrm((DEPTH, HY_CONV, HY_W * (HY_ORDER + 1)), HY_CONV ** -0.5),
        "hy_conv_b": nrm((DEPTH, HY_W * (HY_ORDER + 1)), 0.01),
        "hy_filt_w1": nrm((DEPTH, HY_EMB, HY_FILT), HY_EMB ** -0.5),
        "hy_filt_b1": nrm((DEPTH, HY_FILT), 0.1),
        "hy_filt_w2": nrm((DEPTH, HY_FILT, HY_FILT), HY_FILT ** -0.5),
        "hy_filt_b2": nrm((DEPTH, HY_FILT), 0.1),
        "hy_filt_w3": nrm((DEPTH, HY_FILT, HY_ORDER * 2 * HY_W), HY_FILT ** -0.5),
        "hy_filt_freq": gain((DEPTH, HY_FILT)),
        "hy_bias": nrm((DEPTH, HY_ORDER, HY_W), 0.5),
        "gqa_q_g": gain((DEPTH, GQA_HEAD_DIM)),
        "gqa_k_g": gain((DEPTH, GQA_HEAD_DIM)),
        "mla_q_g": gain((DEPTH, MLA_Q_RANK)),
        "mla_kv_g": gain((DEPTH, MLA_KV_RANK)),
        "mla_w_uq": nrm((DEPTH, MLA_Q_RANK, MLA_HEADS * MLA_QK_DIM), MLA_Q_RANK ** -0.5),
        "mla_w_ukv": nrm((DEPTH, MLA_KV_RANK, MLA_HEADS * (MLA_NOPE_DIM + MLA_V_DIM)), MLA_KV_RANK ** -0.5),
        "w_out": nrm((DEPTH, MIX_WIDTH, D), MIX_WIDTH ** -0.5),
        "ffn_w1": nrm((DEPTH, D, FFN_HIDDEN), D ** -0.5),
        "ffn_w3": nrm((DEPTH, D, FFN_HIDDEN), D ** -0.5),
        "ffn_w2": nrm((DEPTH, FFN_HIDDEN, D), FFN_HIDDEN ** -0.5),
        "final_g": gain((D,)),
    }


def reference(x, c, ctx, c_ctx, mod_w, mod_b, norm1_g, norm2_g, w_in, hy_conv_w, hy_conv_b,
              hy_filt_w1, hy_filt_b1, hy_filt_w2, hy_filt_b2, hy_filt_w3, hy_filt_freq, hy_bias,
              gqa_q_g, gqa_k_g, mla_q_g, mla_kv_g, mla_w_uq, mla_w_ukv, w_out,
              ffn_w1, ffn_w3, ffn_w2, final_g):
    B, n_lat, D = x.shape
    n_rows = n_lat // GRID_W
    row = jnp.repeat(jnp.arange(n_rows, dtype=jnp.int32), GRID_W)
    col = jnp.tile(jnp.arange(GRID_W, dtype=jnp.int32), n_rows)
    off = np.cumsum((0,) + IN_SPLITS).tolist()

    x_lat, x_ctx = x, ctx
    sc = jax.nn.silu(c)
    sc_ctx = jax.nn.silu(c_ctx)
    for l in range(DEPTH):
        last = l == DEPTH - 1
        lp = {
            "hy_conv_w": hy_conv_w[l], "hy_conv_b": hy_conv_b[l],
            "hy_filt_w1": hy_filt_w1[l], "hy_filt_b1": hy_filt_b1[l],
            "hy_filt_w2": hy_filt_w2[l], "hy_filt_b2": hy_filt_b2[l],
            "hy_filt_w3": hy_filt_w3[l], "hy_filt_freq": hy_filt_freq[l], "hy_bias": hy_bias[l],
            "gqa_q_g": gqa_q_g[l], "gqa_k_g": gqa_k_g[l],
            "mla_q_g": mla_q_g[l], "mla_kv_g": mla_kv_g[l],
            "mla_w_uq": mla_w_uq[l], "mla_w_ukv": mla_w_ukv[l],
        }
        w_in_l, w_out_l = w_in[l], w_out[l]

        mod = (sc @ mod_w[l] + mod_b[l]).reshape(B, N_MOD, D)
        shift1, scale1, gate1, shift2, scale2, gate2 = [mod[:, i, None, :] for i in range(N_MOD)]
        n_ctx_mod = 2 if last else N_MOD
        mod_c = (sc_ctx @ mod_w[l][:, :n_ctx_mod * D] + mod_b[l][:n_ctx_mod * D]).reshape(n_ctx_mod, D)

        h_c = rmsnorm(x_ctx, norm1_g[l]) * (1.0 + mod_c[1]) + mod_c[0]
        if last:
            w_kv = jnp.concatenate([w_in_l[:, off[2]:off[4]], w_in_l[:, off[5]:off[7]]], axis=1)
            gk_c, gv_c, mkv_c, mkr_c = split_cols(h_c @ w_kv, IN_SPLITS[2:4] + IN_SPLITS[5:7])
            kv_c = attn_keys_values(gk_c, gv_c, mkv_c, mkr_c, lp, None, None)
        else:
            hy_c, gq_c, gk_c, gv_c, mq_c, mkv_c, mkr_c = split_cols(h_c @ w_in_l, IN_SPLITS)
            kv_c = attn_keys_values(gk_c, gv_c, mkv_c, mkr_c, lp, None, None)
            q_c = attn_queries(gq_c, mq_c, lp, None, None)
            y_c = merge_heads(hyena_mixer(hy_c, lp), attend(q_c, kv_c), w_out_l)
            x_ctx_mid = x_ctx + mod_c[2] * y_c

        h = rmsnorm(x_lat, norm1_g[l]) * (1.0 + scale1) + shift1
        hy, gq, gk, gv, mq, mkv, mkr = split_cols(h @ w_in_l, IN_SPLITS)
        q = attn_queries(gq, mq, lp, row, col)
        kv = attn_keys_values(gk, gv, mkv, mkr, lp, row, col)
        kv_all = tuple(jnp.concatenate([a_c, a_l], axis=1) for a_c, a_l in zip(kv_c, kv))
        y = merge_heads(hyena_mixer(hy, lp), attend(q, kv_all), w_out_l)
        x_lat = x_lat + gate1 * y

        h2 = rmsnorm(x_lat, norm2_g[l]) * (1.0 + scale2) + shift2
        x_lat = x_lat + gate2 * swiglu(h2, ffn_w1[l], ffn_w3[l], ffn_w2[l])
        if not last:
            h2_c = rmsnorm(x_ctx_mid, norm2_g[l]) * (1.0 + mod_c[4]) + mod_c[3]
            x_ctx = x_ctx_mid + mod_c[5] * swiglu(h2_c, ffn_w1[l], ffn_w3[l], ffn_w2[l])

    return rmsnorm(x_lat, final_g)
```

```cpp
#include <hip/hip_runtime.h>
#include <hip/hip_cooperative_groups.h>
#include <cstdio>
#include <cstdint>
namespace cg = cooperative_groups;

#define DI __device__ __forceinline__
typedef unsigned short bf16_t;
typedef short bf16x8 __attribute__((ext_vector_type(8)));
typedef float f32x16 __attribute__((ext_vector_type(16)));
#define MFMA32(a, b, c) __builtin_amdgcn_mfma_f32_32x32x16_bf16((a), (b), (c), 0, 0, 0)

constexpr int D = 1024, NB = 8, SEQ = 4096, CTX = 256, NLAT = NB * SEQ, NCTXR = NB * CTX, NTOK = NLAT + NCTXR;
constexpr int NKEY = CTX + SEQ;
constexpr int INW = 1824, INP = 1920, FFH = 2816;
constexpr int THREADS = 256;
constexpr int XCD_BAR_WORDS_C = 3456;
constexpr float LOG2E = 1.4426950408889634f;

constexpr size_t SZ_U = (size_t)NTOK * INP * 2;
constexpr size_t OFF_U = 0;
constexpr size_t OFF_QG = OFF_U + SZ_U;
constexpr size_t OFF_KG = OFF_QG + (size_t)NB * 6 * NKEY * 64 * 2;
constexpr size_t OFF_VGT = OFF_KG + (size_t)NB * 2 * NKEY * 64 * 2;
constexpr size_t OFF_QM = OFF_VGT + (size_t)NB * 2 * NKEY * 64 * 2;
constexpr size_t OFF_KM = OFF_QM + (size_t)NB * 6 * NKEY * 96 * 2;
constexpr size_t OFF_VMT = OFF_KM + (size_t)NB * 6 * NKEY * 96 * 2;
constexpr size_t OFF_MQN = OFF_VMT + (size_t)NB * 6 * NKEY * 64 * 2;
constexpr size_t OFF_MKVN = OFF_MQN + (size_t)NTOK * 256 * 2;
constexpr size_t OFF_HT = OFF_MKVN + (size_t)NTOK * 128 * 2;
constexpr size_t OFF_H = OFF_HT + (size_t)3 * NB * 256 * SEQ * 2;
constexpr size_t OFF_XCTX = OFF_H + (size_t)NTOK * D * 2;
constexpr size_t OFF_W = OFF_XCTX + (size_t)NCTXR * D * 4;
constexpr size_t W_IN = 0, W_OUT = W_IN + (size_t)INP * D, W_13 = W_OUT + (size_t)D * D, W_2 = W_13 + (size_t)2 * FFH * D,
                 W_UQ = W_2 + (size_t)D * FFH, W_UKV = W_UQ + (size_t)640 * 256, WL = W_UKV + (size_t)768 * 128;
constexpr size_t OFF_MOD = OFF_W + 2 * WL * 2;
constexpr size_t OFF_MODP = OFF_MOD + (size_t)2 * 9 * 6144 * 4;
constexpr size_t OFF_KREV = OFF_MODP + (size_t)2 * 8 * 9 * 6144 * 4;
constexpr size_t OFF_KREVC = OFF_KREV + (size_t)2 * 2 * 256 * 8192 * 2;
constexpr size_t OFF_PN = OFF_KREVC + (size_t)2 * 256 * 512 * 4;
constexpr size_t OFF_PNC = OFF_PN + (size_t)2 * 256 * 512 * 4;
constexpr size_t OFF_ROPEG = OFF_PNC + (size_t)16 * 512 * 4;
constexpr size_t OFF_ROPEM = OFF_ROPEG + (size_t)64 * 16 * 8;
constexpr size_t OFF_BAR = OFF_ROPEM + (size_t)64 * 8 * 8;
constexpr size_t WS_NEED = OFF_BAR + (size_t)XCD_BAR_WORDS_C * 4;

struct Params {
  const float *x, *c, *ctx, *c_ctx, *mod_w, *mod_b, *norm1_g, *norm2_g, *w_in, *hy_conv_w, *hy_conv_b, *hy_filt_w1, *hy_filt_b1,
      *hy_filt_w2, *hy_filt_b2, *hy_filt_w3, *hy_filt_freq, *hy_bias, *gqa_q_g, *gqa_k_g, *mla_q_g, *mla_kv_g, *mla_w_uq, *mla_w_ukv,
      *w_out, *ffn_w1, *ffn_w3, *ffn_w2, *final_g;
  float* out;
  char* ws;
};

typedef float f32x2_t __attribute__((ext_vector_type(2)));
typedef __bf16 bf16x2_t __attribute__((ext_vector_type(2)));
typedef unsigned u32x4 __attribute__((ext_vector_type(4)));
DI unsigned pack2(float lo, float hi) { f32x2_t v = {lo, hi}; bf16x2_t r = __builtin_convertvector(v, bf16x2_t); return __builtin_bit_cast(unsigned, r); }
DI bf16_t f2bf(float x) { return (bf16_t)(pack2(x, x) & 0xffffu); }
DI float bf2f(bf16_t v) { return __uint_as_float(((unsigned)v) << 16); }
DI bf16x8 pack8(float a0, float a1, float a2, float a3, float a4, float a5, float a6, float a7) {
  u32x4 p = {pack2(a0, a1), pack2(a2, a3), pack2(a4, a5), pack2(a6, a7)};
  return __builtin_bit_cast(bf16x8, p);
}
DI float wave_sum(float v) {
#pragma unroll
  for (int o = 32; o > 0; o >>= 1) v += __shfl_xor(v, o);
  return v;
}
DI int get_tid() { int t = threadIdx.x; asm volatile("" : "+v"(t)); return t; }
DI float xhalf_max(float x) { auto r = __builtin_amdgcn_permlane32_swap(__float_as_uint(x), __float_as_uint(x), false, false); return fmaxf(__uint_as_float(r[0]), __uint_as_float(r[1])); }
DI float xhalf_sum(float x) { auto r = __builtin_amdgcn_permlane32_swap(__float_as_uint(x), __float_as_uint(x), false, false); return __uint_as_float(r[0]) + __uint_as_float(r[1]); }
DI int crow(int reg, int h) { return (reg & 3) + 8 * (reg >> 2) + 4 * h; }
DI void sincos_acc(float x, float& s, float& c) {
  float k = rintf(x * 0.63661977236758134f);
  int q = (int)k;
  float r = fmaf(k, -1.5707963705062866f, x);
  r = fmaf(k, 4.3711388286737929e-8f, r);
  float r2 = r * r;
  float sp = r + r * r2 * (-1.6666654611e-1f + r2 * (8.3321608736e-3f + r2 * (-1.9515295891e-4f)));
  float cp = 1.0f - 0.5f * r2 + r2 * r2 * (4.166664568298827e-2f + r2 * (-1.388731625493765e-3f + r2 * 2.443315711809948e-5f));
  switch (q & 3) {
    case 0: s = sp; c = cp; break;
    case 1: s = cp; c = -sp; break;
    case 2: s = -sp; c = -cp; break;
    default: s = -cp; c = sp; break;
  }
}
DI float sin_acc(float x) { float s, c; sincos_acc(x, s, c); return s; }
DI float silu_f(float x) { return x * __builtin_amdgcn_rcpf(1.0f + __expf(-x)); }

DI void row_info(int row, int& b, int& kp) {
  if (row < NLAT) { b = row >> 12; kp = CTX + (row & 4095); }
  else { int r = row - NLAT; b = r >> 8; kp = r & 255; }
}
DI int row_of(int b, int kp) { return kp < CTX ? NLAT + b * CTX + kp : b * SEQ + (kp - CTX); }
DI const float* xold_ptr(const Params& p, int layer, bool first, int row) {
  if (row < NLAT) return (first ? p.x : p.out) + (size_t)row * D;
  return (first ? p.ctx : (const float*)(p.ws + OFF_XCTX)) + (size_t)(row - NLAT) * D;
}
DI float* xnew_ptr(const Params& p, int row) {
  if (row < NLAT) return p.out + (size_t)row * D;
  return (float*)(p.ws + OFF_XCTX) + (size_t)(row - NLAT) * D;
}
DI void tile_map(int t, int MT, int NT, int& mt, int& nt) {
  const int xc = t & 7, j = t >> 3, mtx = MT >> 3, full = NT >> 3, per = mtx * 8;
  int sc = j / per, rem, w;
  if (sc < full) { rem = j - sc * per; w = 8; }
  else { sc = full; rem = j - full * per; w = NT & 7; }
  const int m = rem / w, nn = rem - m * w;
  mt = xc * mtx + m; nt = sc * 8 + nn;
}

constexpr int LDT = 72;
enum { EPI_U = 0, EPI_RES1, EPI_SWIGLU, EPI_RES2, EPI_QUP, EPI_KVUP };

template <int EPI>
DI void epilogue(const Params& p, int layer, f32x16 (&acc)[2][2], int mrow0, int ncol0, int lane) {
  const int c = lane & 31, h = lane >> 5;
  if (EPI == EPI_U) {
    if (ncol0 < 768 && mrow0 < NLAT) {
      bf16_t* HT = (bf16_t*)(p.ws + OFF_HT);
#pragma unroll
      for (int ni = 0; ni < 2; ++ni) {
        const int col = ncol0 + ni * 32 + c, which = col >> 8, ch = col & 255;
#pragma unroll
        for (int mi = 0; mi < 2; ++mi)
#pragma unroll
          for (int g = 0; g < 4; ++g) {
            const int row0 = mrow0 + mi * 32 + 8 * g + 4 * h, bq = row0 >> 12, s0 = row0 & 4095;
            uint2 w;
            w.x = pack2(acc[mi][ni][4 * g], acc[mi][ni][4 * g + 1]);
            w.y = pack2(acc[mi][ni][4 * g + 2], acc[mi][ni][4 * g + 3]);
            *(uint2*)(HT + (((size_t)which * NB + bq) * 256 + ch) * SEQ + s0) = w;
          }
      }
    } else if (ncol0 >= 1280 && ncol0 < 1408) {
      bf16_t* Vgt = (bf16_t*)(p.ws + OFF_VGT);
      const int kh = (ncol0 - 1280) >> 6;
#pragma unroll
      for (int ni = 0; ni < 2; ++ni) {
        const int dv = ni * 32 + c;
#pragma unroll
        for (int mi = 0; mi < 2; ++mi)
#pragma unroll
          for (int g = 0; g < 4; ++g) {
            int bq, kp; row_info(mrow0 + mi * 32 + 8 * g + 4 * h, bq, kp);
            uint2 w;
            w.x = pack2(acc[mi][ni][4 * g], acc[mi][ni][4 * g + 1]);
            w.y = pack2(acc[mi][ni][4 * g + 2], acc[mi][ni][4 * g + 3]);
            *(uint2*)(Vgt + ((size_t)(bq * 2 + kh) * 64 + dv) * NKEY + kp) = w;
          }
      }
    } else {
      bf16_t* U = (bf16_t*)(p.ws + OFF_U);
#pragma unroll
      for (int mi = 0; mi < 2; ++mi)
#pragma unroll
        for (int ni = 0; ni < 2; ++ni)
#pragma unroll
          for (int r = 0; r < 16; ++r) {
            int row = mrow0 + mi * 32 + crow(r, h), col = ncol0 + ni * 32 + c;
            U[(size_t)row * INP + col] = f2bf(acc[mi][ni][r]);
          }
    }
  } else if (EPI == EPI_RES1 || EPI == EPI_RES2) {
    const float* mod = (const float*)(p.ws + OFF_MOD) + (size_t)layer * 9 * 6144;
    const int b9 = mrow0 < NLAT ? (mrow0 >> 12) : 8;
    const int gsel = (EPI == EPI_RES1) ? 2 : 5;
    const bool first = (EPI == EPI_RES1) && layer == 0;
    const float* xo_base = xold_ptr(p, layer, first, mrow0) + (ncol0 + c);
    float* xn_base = xnew_ptr(p, mrow0) + (ncol0 + c);
    float gate[2];
#pragma unroll
    for (int ni = 0; ni < 2; ++ni) gate[ni] = mod[b9 * 6144 + gsel * 1024 + ncol0 + ni * 32 + c];
    float xa[16], xb[16];
#define RES_LD(X, mi_, ni_) { _Pragma("unroll") for (int r = 0; r < 16; ++r) X[r] = xo_base[(size_t)((mi_) * 32 + crow(r, h)) * D + (ni_) * 32]; }
#define RES_ST(X, mi_, ni_) { _Pragma("unroll") for (int r = 0; r < 16; ++r) xn_base[(size_t)((mi_) * 32 + crow(r, h)) * D + (ni_) * 32] = X[r] + gate[ni_] * acc[mi_][ni_][r]; }
    RES_LD(xa, 0, 0)
    RES_LD(xb, 0, 1)
    RES_ST(xa, 0, 0)
    RES_LD(xa, 1, 0)
    RES_ST(xb, 0, 1)
    RES_LD(xb, 1, 1)
    RES_ST(xa, 1, 0)
    RES_ST(xb, 1, 1)
#undef RES_LD
#undef RES_ST
  } else if (EPI == EPI_SWIGLU) {
    bf16_t* G = (bf16_t*)(p.ws + OFF_U);
    const int j = (ncol0 >> 7) * 64 + ((ncol0 >> 6) & 1) * 32 + c;
#pragma unroll
    for (int mi = 0; mi < 2; ++mi)
#pragma unroll
      for (int r = 0; r < 16; ++r) {
        int row = mrow0 + mi * 32 + crow(r, h);
        float a1 = acc[mi][0][r], a3 = acc[mi][1][r];
        G[(size_t)row * FFH + j] = f2bf(silu_f(a1) * a3);
      }
  } else if (EPI == EPI_QUP) {
    bf16_t* Qm = (bf16_t*)(p.ws + OFF_QM);
    const float2* csm = (const float2*)(p.ws + OFF_ROPEM);
    const float qs = 0.10206207261596577f * LOG2E;
    const bool lat = mrow0 < NLAT;
    float2 cst[2][16];
#pragma unroll
    for (int mi = 0; mi < 2; ++mi)
#pragma unroll
      for (int r = 0; r < 16; ++r) {
        const int sq = (mrow0 + mi * 32 + crow(r, h)) & 4095;
        const int pos = (c >> 4) ? (sq & 63) : (sq >> 6);
        cst[mi][r] = lat ? csm[pos * 8 + (c & 7)] : make_float2(1.f, 0.f);
      }
#pragma unroll
    for (int ni = 0; ni < 2; ++ni) {
      int cg0 = ncol0 + ni * 32;
      if (cg0 >= 576) continue;
      int head = cg0 / 96, part = (cg0 % 96) >> 5;
#pragma unroll
      for (int mi = 0; mi < 2; ++mi)
#pragma unroll
        for (int r = 0; r < 16; ++r) {
          int row = mrow0 + mi * 32 + crow(r, h);
          int b, kp; row_info(row, b, kp);
          float v = acc[mi][ni][r];
          if (part == 2) {
            float pv = __shfl_xor(v, 8);
            if (lat) {
              const float2 cs = cst[mi][r];
              v = v * cs.x + ((c & 8) ? pv : -pv) * cs.y;
            }
          }
          Qm[((size_t)(b * 6 + head) * NKEY + kp) * 96 + part * 32 + c] = f2bf(v * qs);
        }
    }
  } else if (EPI == EPI_KVUP) {
    bf16_t* Km = (bf16_t*)(p.ws + OFF_KM);
    bf16_t* Vmt = (bf16_t*)(p.ws + OFF_VMT);
#pragma unroll
    for (int ni = 0; ni < 2; ++ni) {
      int cg0 = ncol0 + ni * 32;
      int head = cg0 >> 7, part = (cg0 >> 5) & 3;
#pragma unroll
      for (int mi = 0; mi < 2; ++mi) {
        if (part < 2) {
#pragma unroll
          for (int r = 0; r < 16; ++r) {
            int row = mrow0 + mi * 32 + crow(r, h);
            int b, kp; row_info(row, b, kp);
            Km[((size_t)(b * 6 + head) * NKEY + kp) * 96 + part * 32 + c] = f2bf(acc[mi][ni][r]);
          }
        } else {
#pragma unroll
          for (int g = 0; g < 4; ++g) {
            int row = mrow0 + mi * 32 + 8 * g + 4 * h;
            int b, kp; row_info(row, b, kp);
            uint2 w;
            w.x = pack2(acc[mi][ni][4 * g], acc[mi][ni][4 * g + 1]);
            w.y = pack2(acc[mi][ni][4 * g + 2], acc[mi][ni][4 * g + 3]);
            *(uint2*)(Vmt + ((size_t)(b * 6 + head) * 64 + (part - 2) * 32 + c) * NKEY + kp) = w;
          }
        }
      }
    }
  }
}

template <int EPI>
DI void gemm_phase(const Params& p, int layer, const bf16_t* __restrict__ A, int lda, const bf16_t* __restrict__ Bt, int ldb, int K, int MT, int NT,
                   char* smem, bool rev = false) {
  bf16_t* sA = (bf16_t*)smem;
  bf16_t* sB = sA + 2 * 128 * LDT;
  const int tid = get_tid(), lane = tid & 63, wave = tid >> 6, wr = wave >> 1, wc = wave & 1;
  const int total = MT * NT;
  int t = rev ? (int)(gridDim.x - 1 - blockIdx.x) : (int)blockIdx.x;
  if (t >= total) return;
  uint4 pa0, pa1, pa2, pa3, pb0, pb1, pb2, pb3, qa0, qa1, qa2, qa3, qb0, qb1, qb2, qb3;
  const int lr = tid >> 3, lc = (tid & 7) * 8;
  const int nk = K >> 6;
  const int soff = lr * LDT + lc;
  const int aoff = (wr * 64 + (lane & 31)) * LDT + (lane >> 5) * 8;
  const int boff = (wc * 64 + (lane & 31)) * LDT + (lane >> 5) * 8;
  int mt, nt; tile_map(t, MT, NT, mt, nt);
  int m0 = mt * 128, n0 = nt * 128;
  const bf16_t* Agl = A + (size_t)(m0 + lr) * lda + lc;
  const bf16_t* Bgl = Bt + (size_t)(n0 + lr) * ldb + lc;
#define G_LOAD(P, k0_)                                                   \
  {                                                                      \
    P##a0 = *(const uint4*)(Agl + (k0_));                                \
    P##a1 = *(const uint4*)(Agl + (size_t)32 * lda + (k0_));             \
    P##a2 = *(const uint4*)(Agl + (size_t)64 * lda + (k0_));             \
    P##a3 = *(const uint4*)(Agl + (size_t)96 * lda + (k0_));             \
    P##b0 = *(const uint4*)(Bgl + (k0_));                                \
    P##b1 = *(const uint4*)(Bgl + (size_t)32 * ldb + (k0_));             \
    P##b2 = *(const uint4*)(Bgl + (size_t)64 * ldb + (k0_));             \
    P##b3 = *(const uint4*)(Bgl + (size_t)96 * ldb + (k0_));             \
  }
#define G_WRITE(P, buf_)                                                 \
  {                                                                      \
    bf16_t* wa_ = sA + (buf_) * 128 * LDT + soff;                        \
    bf16_t* wb_ = sB + (buf_) * 128 * LDT + soff;                        \
    *(uint4*)(wa_) = P##a0; *(uint4*)(wa_ + 32 * LDT) = P##a1;           \
    *(uint4*)(wa_ + 64 * LDT) = P##a2; *(uint4*)(wa_ + 96 * LDT) = P##a3;\
    *(uint4*)(wb_) = P##b0; *(uint4*)(wb_ + 32 * LDT) = P##b1;           \
    *(uint4*)(wb_ + 64 * LDT) = P##b2; *(uint4*)(wb_ + 96 * LDT) = P##b3;\
  }
#define G_COMPUTE(buf_)                                                            \
  {                                                                                \
    const bf16_t* a_base = sA + (buf_) * 128 * LDT + aoff;                         \
    const bf16_t* b_base = sB + (buf_) * 128 * LDT + boff;                         \
    __builtin_amdgcn_s_setprio(1);                                                 \
    _Pragma("unroll") for (int ks = 0; ks < 4; ++ks) {                             \
      bf16x8 a0 = *(const bf16x8*)(a_base + ks * 16);                              \
      bf16x8 a1 = *(const bf16x8*)(a_base + 32 * LDT + ks * 16);                   \
      bf16x8 b0 = *(const bf16x8*)(b_base + ks * 16);                              \
      bf16x8 b1 = *(const bf16x8*)(b_base + 32 * LDT + ks * 16);                   \
      acc[0][0] = MFMA32(a0, b0, acc[0][0]);                                       \
      acc[0][1] = MFMA32(a0, b1, acc[0][1]);                                       \
      acc[1][0] = MFMA32(a1, b0, acc[1][0]);                                       \
      acc[1][1] = MFMA32(a1, b1, acc[1][1]);                                       \
    }                                                                              \
    __builtin_amdgcn_s_setprio(0);                                                 \
  }
  G_LOAD(p, 0)
  G_LOAD(q, 64)
  for (;;) {
    G_WRITE(p, 0)
    __syncthreads();
    if (nk > 2) G_LOAD(p, 128)
    f32x16 acc[2][2];
#pragma unroll
    for (int i = 0; i < 2; ++i)
#pragma unroll
      for (int j = 0; j < 2; ++j)
#pragma unroll
        for (int r = 0; r < 16; ++r) acc[i][j][r] = 0.f;
    for (int kt = 0; kt < nk; kt += 2) {
      G_COMPUTE(0)
      G_WRITE(q, 1)
      __syncthreads();
      if (kt + 3 < nk) G_LOAD(q, (kt + 3) << 6)
      G_COMPUTE(1)
      if (kt + 2 < nk) G_WRITE(p, 0)
      __syncthreads();
      if (kt + 4 < nk) G_LOAD(p, (kt + 4) << 6)
    }
    const int tn = t + gridDim.x;
    const bool has_next = tn < total;
    const int m0c = m0, n0c = n0;
    constexpr bool PRE = (EPI != EPI_QUP && EPI != EPI_RES1 && EPI != EPI_RES2);
    if (has_next) {
      tile_map(tn, MT, NT, mt, nt);
      m0 = mt * 128; n0 = nt * 128;
      Agl = A + (size_t)(m0 + lr) * lda + lc;
      Bgl = Bt + (size_t)(n0 + lr) * ldb + lc;
      if (PRE) { G_LOAD(p, 0) G_LOAD(q, 64) }
    }
    epilogue<EPI>(p, layer, acc, m0c + wr * 64, n0c + wc * 64, lane);
    if (!has_next) break;
    if (!PRE) { G_LOAD(p, 0) G_LOAD(q, 64) }
    t = tn;
  }
#undef G_LOAD
#undef G_WRITE
#undef G_COMPUTE
}

struct TrItem { const float* src; bf16_t* dst; int K, N, mode, k0, n0; };
DI TrItem tr_decode(const Params& p, int it) {
  constexpr int T_IN = 16 * 30, T_OUT = 16 * 16, T_W1 = 16 * 44, T_W3 = 16 * 44, T_W2 = 44 * 16, T_UQ = 4 * 10, T_UKV = 2 * 12;
  constexpr int T_LAYER = T_IN + T_OUT + T_W1 + T_W3 + T_W2 + T_UQ + T_UKV;
  const int layer = it / T_LAYER;
  int r = it % T_LAYER;
  bf16_t* wl = (bf16_t*)(p.ws + OFF_W) + (size_t)layer * WL;
  TrItem t;
  int nt;
  if (r < T_IN) { t.src = p.w_in + (size_t)layer * D * INW; t.K = D; t.N = INW; t.dst = wl + W_IN; t.mode = 0; nt = 30; }
  else if ((r -= T_IN) < T_OUT) { t.src = p.w_out + (size_t)layer * D * D; t.K = D; t.N = D; t.dst = wl + W_OUT; t.mode = 0; nt = 16; }
  else if ((r -= T_OUT) < T_W1) { t.src = p.ffn_w1 + (size_t)layer * D * FFH; t.K = D; t.N = FFH; t.dst = wl + W_13; t.mode = 1; nt = 44; }
  else if ((r -= T_W1) < T_W3) { t.src = p.ffn_w3 + (size_t)layer * D * FFH; t.K = D; t.N = FFH; t.dst = wl + W_13; t.mode = 2; nt = 44; }
  else if ((r -= T_W3) < T_W2) { t.src = p.ffn_w2 + (size_t)layer * FFH * D; t.K = FFH; t.N = D; t.dst = wl + W_2; t.mode = 0; nt = 16; }
  else if ((r -= T_W2) < T_UQ) { t.src = p.mla_w_uq + (size_t)layer * 256 * 576; t.K = 256; t.N = 576; t.dst = wl + W_UQ; t.mode = 0; nt = 10; }
  else { r -= T_UQ; t.src = p.mla_w_ukv + (size_t)layer * 128 * 768; t.K = 128; t.N = 768; t.dst = wl + W_UKV; t.mode = 0; nt = 12; }
  t.k0 = (r / nt) * 64; t.n0 = (r % nt) * 64;
  return t;
}
DI void transpose_loop(const Params& p, int n_items, char* smem) {
  bf16_t* sT = (bf16_t*)smem;
  const int tid = get_tid();
  int it = blockIdx.x;
  if (it >= n_items) return;
  const int kr0 = tid >> 4, c4 = tid & 15;
  TrItem cur = tr_decode(p, it);
  float4 v0, v1, v2, v3, w0, w1, w2, w3;
#define TR_LOAD(T, V0, V1, V2, V3)                                                                  \
  {                                                                                                 \
    const int n_ = T.n0 + c4 * 4;                                                                   \
    const float* sp_ = T.src + (size_t)(T.k0 + kr0) * T.N + (n_ < T.N ? n_ : 0);                    \
    V0 = *(const float4*)(sp_); V1 = *(const float4*)(sp_ + (size_t)16 * T.N);                     \
    V2 = *(const float4*)(sp_ + (size_t)32 * T.N); V3 = *(const float4*)(sp_ + (size_t)48 * T.N);   \
    if (n_ >= T.N) { V0 = make_float4(0.f, 0.f, 0.f, 0.f); V1 = V0; V2 = V0; V3 = V0; }             \
  }
  TR_LOAD(cur, v0, v1, v2, v3)
  for (;;) {
    const int itn = it + gridDim.x;
    const bool has = itn < n_items;
    TrItem nxt = cur;
    if (has) { nxt = tr_decode(p, itn); TR_LOAD(nxt, w0, w1, w2, w3) }
#define TR_PUT(V, i_)                                                     \
    {                                                                     \
      const int kr_ = kr0 + 16 * (i_);                                    \
      sT[(c4 * 4 + 0) * 66 + kr_] = f2bf(V.x); sT[(c4 * 4 + 1) * 66 + kr_] = f2bf(V.y); \
      sT[(c4 * 4 + 2) * 66 + kr_] = f2bf(V.z); sT[(c4 * 4 + 3) * 66 + kr_] = f2bf(V.w); \
    }
    TR_PUT(v0, 0) TR_PUT(v1, 1) TR_PUT(v2, 2) TR_PUT(v3, 3)
    __syncthreads();
#pragma unroll
    for (int i = 0; i < 2; ++i) {
      int id = tid + 256 * i, n = id >> 3, k8 = id & 7;
      const unsigned* sp = (const unsigned*)(sT + n * 66 + k8 * 8);
      uint4 w; w.x = sp[0]; w.y = sp[1]; w.z = sp[2]; w.w = sp[3];
      int j = cur.n0 + n, drow = j;
      if (cur.mode != 0) drow = 128 * (j >> 6) + 64 * ((j >> 5) & 1) + (j & 31) + (cur.mode == 2 ? 32 : 0);
      *(uint4*)(cur.dst + (size_t)drow * cur.K + cur.k0 + k8 * 8) = w;
    }
    __syncthreads();
    if (!has) break;
    it = itn; cur = nxt; v0 = w0; v1 = w1; v2 = w2; v3 = w3;
  }
#undef TR_LOAD
#undef TR_PUT
}

DI void modpart_item(const Params& p, int layer, int cb, int ks, char* smem) {
  float* sc = (float*)smem;
  const int tid = get_tid();
  for (int i = tid; i < 9 * 128; i += 256) {
    int b = i >> 7, k = ks * 128 + (i & 127);
    float v = b < 8 ? p.c[b * D + k] : p.c_ctx[k];
    sc[i] = silu_f(v);
  }
  __syncthreads();
  const int n = cb * 256 + tid;
  const float* w = p.mod_w + (size_t)layer * D * 6144 + (size_t)(ks * 128) * 6144 + n;
  float a0 = 0, a1 = 0, a2 = 0, a3 = 0, a4 = 0, a5 = 0, a6 = 0, a7 = 0, a8 = 0;
#pragma unroll 4
  for (int k = 0; k < 128; ++k) {
    float wv = w[(size_t)k * 6144];
    a0 += sc[k] * wv; a1 += sc[128 + k] * wv; a2 += sc[256 + k] * wv; a3 += sc[384 + k] * wv; a4 += sc[512 + k] * wv;
    a5 += sc[640 + k] * wv; a6 += sc[768 + k] * wv; a7 += sc[896 + k] * wv; a8 += sc[1024 + k] * wv;
  }
  float* dst = (float*)(p.ws + OFF_MODP) + ((size_t)(layer * 8 + ks) * 9) * 6144 + n;
  dst[0 * 6144] = a0; dst[1 * 6144] = a1; dst[2 * 6144] = a2; dst[3 * 6144] = a3; dst[4 * 6144] = a4;
  dst[5 * 6144] = a5; dst[6 * 6144] = a6; dst[7 * 6144] = a7; dst[8 * 6144] = a8;
  __syncthreads();
}

DI void filter_item(const Params& p, int layer, int L, int tile, char* smem) {
  float* z = (float*)smem;
  float* h1 = z + 16 * 33;
  float* h2 = h1 + 16 * 64;
  const int tid = get_tid(), m0 = tile * 16;
  const float* w1 = p.hy_filt_w1 + (size_t)layer * 33 * 64;
  const float* b1 = p.hy_filt_b1 + layer * 64;
  const float* w2 = p.hy_filt_w2 + (size_t)layer * 64 * 64;
  const float* b2 = p.hy_filt_b2 + layer * 64;
  const float* w3 = p.hy_filt_w3 + (size_t)layer * 64 * 1024;
  const float* fq = p.hy_filt_freq + layer * 64;
  for (int i = tid; i < 16 * 33; i += 256) {
    int ml = i / 33, e = i % 33, m = m0 + ml;
    float val;
    if (e == 0) val = (float)m / (float)(L - 1);
    else {
      int bi = (e - 1) & 15;
      float f = 1e-4f + (float)bi * ((15.0f - 1e-4f) / 15.0f);
      float wpos = (6.283185307179586f * (float)m) / (float)L;
      float s, c; sincos_acc(f * wpos, s, c);
      val = (e <= 16) ? c : -s;
    }
    z[i] = val;
  }
  __syncthreads();
  for (int i = tid; i < 16 * 64; i += 256) {
    int ml = i >> 6, j = i & 63;
    float a = b1[j];
    for (int e = 0; e < 33; ++e) a += z[ml * 33 + e] * w1[e * 64 + j];
    h1[i] = sin_acc(fq[j] * a);
  }
  __syncthreads();
  for (int i = tid; i < 16 * 64; i += 256) {
    int ml = i >> 6, j = i & 63;
    float a = b2[j];
    for (int e = 0; e < 64; ++e) a += h1[ml * 64 + e] * w2[e * 64 + j];
    h2[i] = sin_acc(fq[j] * a);
  }
  __syncthreads();
  const int ch = tid;
  const float da = -15.350567286626972f, db = -3.0701134573253944f;
  const float delta = fabsf(da + (float)ch * ((db - da) / 255.0f));
  float ps0 = 0.f, ps1 = 0.f;
  float fa[16][4];
#pragma unroll
  for (int ml = 0; ml < 16; ++ml) { fa[ml][0] = 0.f; fa[ml][1] = 0.f; fa[ml][2] = 0.f; fa[ml][3] = 0.f; }
  for (int e = 0; e < 64; ++e) {
    const float* wr = w3 + e * 1024 + ch;
    const float w0 = wr[0], w1v = wr[256], w2v = wr[512], w3v = wr[768];
#pragma unroll
    for (int ml = 0; ml < 16; ++ml) {
      const float hv = h2[ml * 64 + e];
      fa[ml][0] += hv * w0; fa[ml][1] += hv * w1v; fa[ml][2] += hv * w2v; fa[ml][3] += hv * w3v;
    }
  }
#pragma unroll
  for (int ml = 0; ml < 16; ++ml) {
    float a00 = fa[ml][0], a01 = fa[ml][1], a10 = fa[ml][2], a11 = fa[ml][3];
    const int m = m0 + ml;
    const float t = (float)m / (float)(L - 1);
    const float dec = __expf(-t * delta);
    a00 *= dec; a01 *= dec; a10 *= dec; a11 *= dec;
    ps0 += fabsf(a00); ps1 += fabsf(a10);
    if (m > 0) { ps0 += fabsf(a01); ps1 += fabsf(a11); }
    if (L == SEQ) {
      bf16_t* k0 = (bf16_t*)(p.ws + OFF_KREV) + ((size_t)(layer * 2 + 0) * 256 + ch) * 8192;
      bf16_t* k1 = (bf16_t*)(p.ws + OFF_KREV) + ((size_t)(layer * 2 + 1) * 256 + ch) * 8192;
      k0[L - 1 - m] = f2bf(a00); k1[L - 1 - m] = f2bf(a10);
      if (m > 0) { k0[L - 1 + m] = f2bf(a01); k1[L - 1 + m] = f2bf(a11); }
      else { k0[2 * L - 1] = 0; k1[2 * L - 1] = 0; }
    } else {
      float* k0 = (float*)(p.ws + OFF_KREVC) + ((size_t)0 * 256 + ch) * 512;
      float* k1 = (float*)(p.ws + OFF_KREVC) + ((size_t)1 * 256 + ch) * 512;
      k0[L - 1 - m] = a00; k1[L - 1 - m] = a10;
      if (m > 0) { k0[L - 1 + m] = a01; k1[L - 1 + m] = a11; }
      else { k0[2 * L - 1] = 0.f; k1[2 * L - 1] = 0.f; }
    }
  }
  float* pn = (L == SEQ) ? (float*)(p.ws + OFF_PN) + ((size_t)layer * 256 + tile) * 512 : (float*)(p.ws + OFF_PNC) + (size_t)tile * 512;
  pn[ch] = ps0; pn[256 + ch] = ps1;
  __syncthreads();
}

DI void phase_prologue(const Params& p, char* smem) {
  constexpr int T_IN = 16 * 30, T_OUT = 16 * 16, T_W1 = 16 * 44, T_W3 = 16 * 44, T_W2 = 44 * 16, T_UQ = 4 * 10, T_UKV = 2 * 12;
  constexpr int T_LAYER = T_IN + T_OUT + T_W1 + T_W3 + T_W2 + T_UQ + T_UKV;
  constexpr int N_TR = 2 * T_LAYER, N_MOD = 2 * 24 * 8, N_FILT = 2 * 256 + 16;
  constexpr int N_ALL = N_TR + N_MOD + N_FILT + 1;
  transpose_loop(p, N_TR, smem);
  for (int it = N_TR + (int)(gridDim.x - 1 - blockIdx.x); it < N_ALL; it += gridDim.x) {
    if (false) {
    } else if (it < N_TR + N_MOD) {
      int r = it - N_TR;
      int layer = r / 192, q = r % 192;
      modpart_item(p, layer, q >> 3, q & 7, smem);
    } else if (it < N_TR + N_MOD + N_FILT) {
      int r = it - N_TR - N_MOD;
      if (r < 512) filter_item(p, r >> 8, SEQ, r & 255, smem);
      else filter_item(p, 0, CTX, r - 512, smem);
    } else {
      float2* cg_ = (float2*)(p.ws + OFF_ROPEG);
      float2* cm_ = (float2*)(p.ws + OFF_ROPEM);
      for (int i = get_tid(); i < 64 * 16; i += 256) {
        int pos = i >> 4, f = i & 15;
        float inv = exp2f(-((float)(2 * f) / 32.0f) * 13.287712379549449f);
        float s, c; sincos_acc((float)pos * inv, s, c);
        cg_[i] = make_float2(c, s);
      }
      for (int i = get_tid(); i < 64 * 8; i += 256) {
        int pos = i >> 3, f = i & 7;
        float inv = exp2f(-((float)(2 * f) / 16.0f) * 13.287712379549449f);
        float s, c; sincos_acc((float)pos * inv, s, c);
        cm_[i] = make_float2(c, s);
      }
    }
  }
}

DI void phase_modfinal(const Params& p) {
  const int total = 2 * 9 * 6144;
  float* mod = (float*)(p.ws + OFF_MOD);
  const float* mp = (const float*)(p.ws + OFF_MODP);
  for (int i = blockIdx.x * 256 + get_tid(); i < total; i += gridDim.x * 256) {
    int layer = i / (9 * 6144), r = i % (9 * 6144), n = r % 6144;
    float a = p.mod_b[layer * 6144 + n];
#pragma unroll
    for (int ks = 0; ks < 8; ++ks) a += mp[((size_t)(layer * 8 + ks) * 9) * 6144 + r];
    mod[i] = a;
  }
}

DI void phase_norm(const Params& p, int layer, int which  , int nrows) {
  const int lane = get_tid() & 63, gw = blockIdx.x * 4 + (get_tid() >> 6), nw = gridDim.x * 4;
  const float* g = (which == 0 ? p.norm1_g : p.norm2_g) + layer * D;
  const float* mod = (const float*)(p.ws + OFF_MOD) + (size_t)layer * 9 * 6144;
  bf16_t* H = (bf16_t*)(p.ws + OFF_H);
  const bool first = (which == 0) && layer == 0;
  for (int pr = gw; pr < (nrows >> 1); pr += nw) {
    const int row = pr * 2;
    const float* xr0 = xold_ptr(p, layer, first, row);
    const float* xr1 = xold_ptr(p, layer, first, row + 1);
    const int b9 = row < NLAT ? (row >> 12) : 8;
    float4 v[2][4];
    float ss0 = 0.f, ss1 = 0.f;
#pragma unroll
    for (int i = 0; i < 4; ++i) { v[0][i] = ((const float4*)xr0)[lane + 64 * i]; v[1][i] = ((const float4*)xr1)[lane + 64 * i]; }
    const float* sh = mod + b9 * 6144 + (which == 0 ? 0 : 3) * 1024;
    const float* sc = sh + 1024;
    float4 gg[4], s4[4], h4[4];
#pragma unroll
    for (int i = 0; i < 4; ++i) {
      const int col = 4 * (lane + 64 * i);
      gg[i] = *(const float4*)(g + col); s4[i] = *(const float4*)(sc + col); h4[i] = *(const float4*)(sh + col);
    }
#pragma unroll
    for (int i = 0; i < 4; ++i) {
      ss0 += v[0][i].x * v[0][i].x + v[0][i].y * v[0][i].y + v[0][i].z * v[0][i].z + v[0][i].w * v[0][i].w;
      ss1 += v[1][i].x * v[1][i].x + v[1][i].y * v[1][i].y + v[1][i].z * v[1][i].z + v[1][i].w * v[1][i].w;
    }
    ss0 = wave_sum(ss0); ss1 = wave_sum(ss1);
    const float rstd0 = rsqrtf(ss0 * (1.0f / D) + 1e-6f), rstd1 = rsqrtf(ss1 * (1.0f / D) + 1e-6f);
#pragma unroll
    for (int k = 0; k < 2; ++k) {
      const float rstd = k == 0 ? rstd0 : rstd1;
#pragma unroll
      for (int i = 0; i < 4; ++i) {
        const int col = 4 * (lane + 64 * i);
        float y0 = v[k][i].x * rstd * gg[i].x * (1.f + s4[i].x) + h4[i].x;
        float y1 = v[k][i].y * rstd * gg[i].y * (1.f + s4[i].y) + h4[i].y;
        float y2 = v[k][i].z * rstd * gg[i].z * (1.f + s4[i].z) + h4[i].z;
        float y3 = v[k][i].w * rstd * gg[i].w * (1.f + s4[i].w) + h4[i].w;
        uint2 w; w.x = pack2(y0, y1); w.y = pack2(y2, y3);
        *(uint2*)(H + (size_t)(row + k) * D + col) = w;
      }
    }
  }
}

DI void phase_final(const Params& p) {
  const int lane = get_tid() & 63, gw = blockIdx.x * 4 + (get_tid() >> 6), nw = gridDim.x * 4;
  for (int pr = gw; pr < (NLAT >> 1); pr += nw) {
    float* xr0 = p.out + (size_t)(2 * pr) * D;
    float* xr1 = xr0 + D;
    float4 v[2][4], gg[4];
    float ss0 = 0.f, ss1 = 0.f;
#pragma unroll
    for (int i = 0; i < 4; ++i) { v[0][i] = ((const float4*)xr0)[lane + 64 * i]; v[1][i] = ((const float4*)xr1)[lane + 64 * i]; }
#pragma unroll
    for (int i = 0; i < 4; ++i) gg[i] = *(const float4*)(p.final_g + 4 * (lane + 64 * i));
#pragma unroll
    for (int i = 0; i < 4; ++i) {
      ss0 += v[0][i].x * v[0][i].x + v[0][i].y * v[0][i].y + v[0][i].z * v[0][i].z + v[0][i].w * v[0][i].w;
      ss1 += v[1][i].x * v[1][i].x + v[1][i].y * v[1][i].y + v[1][i].z * v[1][i].z + v[1][i].w * v[1][i].w;
    }
    ss0 = wave_sum(ss0); ss1 = wave_sum(ss1);
    const float r0 = rsqrtf(ss0 * (1.0f / D) + 1e-6f), r1 = rsqrtf(ss1 * (1.0f / D) + 1e-6f);
#pragma unroll
    for (int i = 0; i < 4; ++i) {
      ((float4*)xr0)[lane + 64 * i] = make_float4(v[0][i].x * r0 * gg[i].x, v[0][i].y * r0 * gg[i].y, v[0][i].z * r0 * gg[i].z, v[0][i].w * r0 * gg[i].w);
      ((float4*)xr1)[lane + 64 * i] = make_float4(v[1][i].x * r1 * gg[i].x, v[1][i].y * r1 * gg[i].y, v[1][i].z * r1 * gg[i].z, v[1][i].w * r1 * gg[i].w);
    }
  }
}

struct PrepRow { bf16_t hv[8]; bf16_t kr; uint2 mq; unsigned mkv; float2 cs, tm; };
DI void prep_row_load(const Params& p, int row, const bf16_t* ur, int lane, PrepRow& R) {
  {
    const float2* csg = (const float2*)(p.ws + OFF_ROPEG);
    const float2* csm = (const float2*)(p.ws + OFF_ROPEM);
    const int s = row & 4095, d = lane & 31;
    const int pg = (lane >> 5) ? (s & 63) : (s >> 6), pm = (d >> 4) ? (s & 63) : (s >> 6);
    R.cs = csg[pg * 16 + (lane & 15)];
    R.tm = csm[pm * 8 + (d & 7)];
    if (row >= NLAT) { R.cs = make_float2(1.f, 0.f); R.tm = make_float2(1.f, 0.f); }
  }
#pragma unroll
  for (int hd = 0; hd < 8; ++hd) R.hv[hd] = ur[768 + hd * 64 + lane];
  R.mq = *(const uint2*)(ur + 1408 + lane * 4);
  R.mkv = *(const unsigned*)(ur + 1664 + lane * 2);
  R.kr = ur[1792 + (lane & 31)];
}
DI void prep_row_store(const Params& p, int layer, int row, int lane, const PrepRow& R, float gq, float gk, float4 g4, float2 g2) {
  bf16_t* Qg = (bf16_t*)(p.ws + OFF_QG);
  bf16_t* Kg = (bf16_t*)(p.ws + OFF_KG);
  bf16_t* Km = (bf16_t*)(p.ws + OFF_KM);
  bf16_t* MQN = (bf16_t*)(p.ws + OFF_MQN);
  bf16_t* MKVN = (bf16_t*)(p.ws + OFF_MKVN);
  const float qs = 0.125f * LOG2E;
  int b, kp; row_info(row, b, kp);
  const bool lat = row < NLAT;
  const int s = row & 4095;
  const float cs_c = R.cs.x, cs_s = R.cs.y;
  const float2 tm = R.tm;
  (void)s;
  const bool upper = (lane >> 4) & 1;
#pragma unroll
  for (int hd = 0; hd < 8; ++hd) {
    float xv = bf2f(R.hv[hd]);
    float ss = wave_sum(xv * xv);
    float y = xv * rsqrtf(ss * (1.0f / 64.f) + 1e-6f) * (hd < 6 ? gq : gk);
    float pv = __shfl_xor(y, 16);
    float o = y * cs_c + (upper ? pv : -pv) * cs_s;
    if (hd < 6) Qg[((size_t)(b * 6 + hd) * NKEY + kp) * 64 + lane] = f2bf(o * qs);
    else Kg[((size_t)(b * 2 + (hd - 6)) * NKEY + kp) * 64 + lane] = f2bf(o);
  }
  {
    const uint2 w = R.mq;
    float x0 = bf2f((bf16_t)(w.x & 0xffff)), x1 = bf2f((bf16_t)(w.x >> 16)), x2 = bf2f((bf16_t)(w.y & 0xffff)), x3 = bf2f((bf16_t)(w.y >> 16));
    float ss = wave_sum(x0 * x0 + x1 * x1 + x2 * x2 + x3 * x3);
    float rstd = rsqrtf(ss * (1.0f / 256.f) + 1e-6f);
    uint2 o; o.x = pack2(x0 * rstd * g4.x, x1 * rstd * g4.y); o.y = pack2(x2 * rstd * g4.z, x3 * rstd * g4.w);
    *(uint2*)(MQN + (size_t)row * 256 + lane * 4) = o;
  }
  {
    const unsigned w = R.mkv;
    float x0 = bf2f((bf16_t)(w & 0xffff)), x1 = bf2f((bf16_t)(w >> 16));
    float ss = wave_sum(x0 * x0 + x1 * x1);
    float rstd = rsqrtf(ss * (1.0f / 128.f) + 1e-6f);
    *(unsigned*)(MKVN + (size_t)row * 128 + lane * 2) = pack2(x0 * rstd * g2.x, x1 * rstd * g2.y);
  }
  {
    int d = lane & 31;
    float xv = bf2f(R.kr);
    float pv = __shfl_xor(xv, 8);
    float o = lat ? (xv * tm.x + ((d & 8) ? pv : -pv) * tm.y) : xv;
    bf16_t ob = f2bf(o);
    int hb = (lane >> 5) * 3;
#pragma unroll
    for (int hh = 0; hh < 3; ++hh) Km[((size_t)(b * 6 + hb + hh) * NKEY + kp) * 96 + 64 + d] = ob;
  }
}
DI void prep_rows(const Params& p, int layer) {
  const int lane = get_tid() & 63, gw = blockIdx.x * 4 + (get_tid() >> 6), nw = gridDim.x * 4;
  const bf16_t* U = (const bf16_t*)(p.ws + OFF_U);
  const float gq = p.gqa_q_g[layer * 64 + lane], gk = p.gqa_k_g[layer * 64 + lane];
  const float4 g4 = *(const float4*)(p.mla_q_g + layer * 256 + lane * 4);
  const float2 g2 = *(const float2*)(p.mla_kv_g + layer * 128 + lane * 2);
  for (int pr = gw; pr < (NTOK >> 1); pr += nw) {
    const int row = pr * 2;
    PrepRow Ra, Rb;
    prep_row_load(p, row, U + (size_t)row * INP, lane, Ra);
    prep_row_load(p, row + 1, U + (size_t)(row + 1) * INP, lane, Rb);
    prep_row_store(p, layer, row, lane, Ra, gq, gk, g4, g2);
    prep_row_store(p, layer, row + 1, lane, Rb, gq, gk, g4, g2);
  }
}

DI void prep_hy_loop(const Params& p, int layer, int n_items, char* smem) {
  bf16_t* sT = (bf16_t*)smem;
  const int tid = get_tid();
  const bf16_t* U = (const bf16_t*)(p.ws + OFF_U);
  bf16_t* HT = (bf16_t*)(p.ws + OFF_HT);
  const int c8 = tid & 7, tk0 = tid >> 3;
  int it = blockIdx.x;
  if (it >= n_items) return;
  uint4 cur[4], prv[4], nxt[4], ncur[4], nprv[4], nnxt[4];
  float w0[8], w1[8], w2[8], wb[8], nw0[8], nw1[8], nw2[8], nwb[8];
#define HY_LOAD(it_, CUR, PRV, NXT, W0, W1, W2, WB)                                           \
  {                                                                                           \
    const int tile_ = (it_) / 12, cgp_ = (it_) % 12;                                          \
    const int row0_ = tile_ * 128, s0_ = row0_ & 4095, ch0_ = cgp_ * 64 + c8 * 8;             \
    const float* cw_ = p.hy_conv_w + (size_t)layer * 3 * 768 + ch0_;                          \
    const float* cb_ = p.hy_conv_b + layer * 768 + ch0_;                                      \
    _Pragma("unroll") for (int i = 0; i < 4; ++i) {                                           \
      const int tk = tk0 + 32 * i, sq = s0_ + tk;                                             \
      const bf16_t* ur = U + (size_t)(row0_ + tk) * INP + ch0_;                               \
      CUR[i] = *(const uint4*)ur;                                                             \
      PRV[i] = *(const uint4*)(ur - (sq > 0 ? INP : 0));                                      \
      NXT[i] = *(const uint4*)(ur + (sq < SEQ - 1 ? INP : 0));                                \
    }                                                                                         \
    _Pragma("unroll") for (int e = 0; e < 8; ++e) { W0[e] = cw_[e]; W1[e] = cw_[768 + e]; W2[e] = cw_[1536 + e]; WB[e] = cb_[e]; } \
  }
  HY_LOAD(it, cur, prv, nxt, w0, w1, w2, wb)
  for (;;) {
    const int itn = it + gridDim.x;
    const bool has = itn < n_items;
    if (has) HY_LOAD(itn, ncur, nprv, nnxt, nw0, nw1, nw2, nwb)
    const int tile = it / 12, cgp = it % 12;
    const int row0 = tile * 128, b = row0 >> 12, s0 = row0 & 4095;
#pragma unroll
    for (int i = 0; i < 4; ++i) {
      const int tk = tk0 + 32 * i, sq = s0 + tk;
      const unsigned mp_ = sq > 0 ? 0xffffffffu : 0u, mn_ = sq < SEQ - 1 ? 0xffffffffu : 0u;
      const unsigned pc[4] = {cur[i].x, cur[i].y, cur[i].z, cur[i].w}, pp[4] = {prv[i].x & mp_, prv[i].y & mp_, prv[i].z & mp_, prv[i].w & mp_},
                     pn[4] = {nxt[i].x & mn_, nxt[i].y & mn_, nxt[i].z & mn_, nxt[i].w & mn_};
#pragma unroll
      for (int e = 0; e < 8; ++e) {
        float xc = bf2f((bf16_t)((pc[e >> 1] >> ((e & 1) * 16)) & 0xffff));
        float xp = bf2f((bf16_t)((pp[e >> 1] >> ((e & 1) * 16)) & 0xffff));
        float xn = bf2f((bf16_t)((pn[e >> 1] >> ((e & 1) * 16)) & 0xffff));
        float o = xp * w0[e] + xc * w1[e] + xn * w2[e] + wb[e];
        sT[(c8 * 8 + e) * 130 + tk] = f2bf(o);
      }
    }
    __syncthreads();
    const int which = cgp >> 2, cbase = (cgp & 3) * 64;
#pragma unroll
    for (int i = 0; i < 4; ++i) {
      int id = tid + 256 * i, ch = id >> 4, t8 = id & 15;
      const unsigned* sp = (const unsigned*)(sT + ch * 130 + t8 * 8);
      uint4 w; w.x = sp[0]; w.y = sp[1]; w.z = sp[2]; w.w = sp[3];
      *(uint4*)(HT + (((size_t)which * NB + b) * 256 + cbase + ch) * SEQ + s0 + t8 * 8) = w;
    }
    __syncthreads();
    if (!has) break;
    it = itn;
#pragma unroll
    for (int i = 0; i < 4; ++i) { cur[i] = ncur[i]; prv[i] = nprv[i]; nxt[i] = nnxt[i]; }
#pragma unroll
    for (int e = 0; e < 8; ++e) { w0[e] = nw0[e]; w1[e] = nw1[e]; w2[e] = nw2[e]; wb[e] = nwb[e]; }
  }
#undef HY_LOAD
}

DI void phase_prep(const Params& p, int layer, char* smem) {
  (void)smem;
  prep_rows(p, layer);
}

constexpr int ZB = 40;
constexpr int ZROW = 192 * ZB;
DI bf16x8 toeplitz_frag(const u32x4& lo, const u32x4& hi, bool b0, bool b1, unsigned sh) {
  const unsigned d0 = lo[0], d1 = lo[1], d2 = lo[2], d3 = lo[3], d4 = hi[0], d5 = hi[1], d6 = hi[2], d7 = hi[3];
  const unsigned t0 = b0 ? d1 : d0, t1 = b0 ? d2 : d1, t2 = b0 ? d3 : d2, t3 = b0 ? d4 : d3, t4 = b0 ? d5 : d4, t5 = b0 ? d6 : d5, t6 = b0 ? d7 : d6;
  const unsigned e0 = b1 ? t2 : t0, e1 = b1 ? t3 : t1, e2 = b1 ? t4 : t2, e3 = b1 ? t5 : t3, e4 = b1 ? t6 : t4;
  u32x4 o = {__builtin_amdgcn_alignbit(e1, e0, sh), __builtin_amdgcn_alignbit(e2, e1, sh), __builtin_amdgcn_alignbit(e3, e2, sh),
             __builtin_amdgcn_alignbit(e4, e3, sh)};
  return __builtin_bit_cast(bf16x8, o);
}
#define HY_BODY(d_)                                                                        \
  {                                                                                        \
    const bf16_t* ap_ = sK + ((SEQ - 1) - 32 * (d_) - r + 8 * h - phi);    \
    const u32x4 w0_ = *(const u32x4*)ap_, w1_ = *(const u32x4*)(ap_ + 8);                  \
    const u32x4 w2_ = *(const u32x4*)(ap_ + 16), w3_ = *(const u32x4*)(ap_ + 24);          \
    const bf16x8 af0_ = toeplitz_frag(w0_, w1_, pb0, pb1, psh);                            \
    const bf16x8 af1_ = toeplitz_frag(w2_, w3_, pb0, pb1, psh);                            \
    const bf16_t* zb_ = sZ + (32 * q + r - (d_) + 32) * ZB + 8 * h;                        \
    _Pragma("unroll") for (int bb_ = 0; bb_ < 4; ++bb_) {                                  \
      const bf16x8 b0_ = *(const bf16x8*)(zb_ + bb_ * ZROW);                               \
      const bf16x8 b1_ = *(const bf16x8*)(zb_ + bb_ * ZROW + 16);                          \
      acc[bb_] = MFMA32(af0_, b0_, acc[bb_]);                                              \
      acc[bb_] = MFMA32(af1_, b1_, acc[bb_]);                                              \
    }                                                                                      \
  }
DI void hyena_conv(const bf16_t* sK, const bf16_t* sZ, f32x16 (&acc)[4], int q, int lane) {
  const int r = lane & 31, h = lane >> 5;
  const int phi = (7 - r) & 7;
  const bool pb0 = (phi >> 1) & 1, pb1 = (phi >> 2) & 1;
  const unsigned psh = (phi & 1) * 16;
#pragma unroll
  for (int bb = 0; bb < 4; ++bb)
#pragma unroll
    for (int i = 0; i < 16; ++i) acc[bb][i] = 0.f;
  int dlo = 32 * q - 127, dhi = 32 * q + 31;
  asm volatile("" : "+s"(dlo), "+s"(dhi));
  for (int d = dlo; d < dhi; d += 2) {
    HY_BODY(d)
    HY_BODY(d + 1)
  }
  HY_BODY(dhi)
}
#undef HY_BODY

struct HyRaw4 { uint2 v; bf16_t m, pz; };
DI HyRaw4 hy_raw4(const bf16_t* u, int t0) {
  HyRaw4 r;
  r.v = *(const uint2*)(u + t0);
  r.m = u[t0 > 0 ? t0 - 1 : 0];
  r.pz = u[t0 + 4 < SEQ ? t0 + 4 : SEQ - 1];
  return r;
}
DI float rbf(float x) { return bf2f(f2bf(x)); }
DI void hy_conv4(const HyRaw4& r, int t0, float w0, float w1, float w2, float wb, float (&o)[4]) {
  const float xm = t0 > 0 ? bf2f(r.m) : 0.f, xp = t0 + 4 < SEQ ? bf2f(r.pz) : 0.f;
  const float e0 = bf2f((bf16_t)(r.v.x & 0xffff)), e1 = bf2f((bf16_t)(r.v.x >> 16)), e2 = bf2f((bf16_t)(r.v.y & 0xffff)), e3 = bf2f((bf16_t)(r.v.y >> 16));
  o[0] = rbf(xm * w0 + e0 * w1 + e1 * w2 + wb);
  o[1] = rbf(e0 * w0 + e1 * w1 + e2 * w2 + wb);
  o[2] = rbf(e1 * w0 + e2 * w1 + e3 * w2 + wb);
  o[3] = rbf(e2 * w0 + e3 * w1 + xp * w2 + wb);
}

DI void hyena_item(const Params& p, int layer, int c, int bh, char* smem) {
  bf16_t* sZ = (bf16_t*)smem;
  bf16_t* sK = sZ + 4 * ZROW;
  float* red = (float*)(sK + 8192);
  const int tid = get_tid(), lane = tid & 63, wave = tid >> 6;
  const bf16_t* HT = (const bf16_t*)(p.ws + OFF_HT);
  const float* cw_ = p.hy_conv_w + (size_t)layer * 3 * 768 + c;
  const float* cb_ = p.hy_conv_b + layer * 768 + c;
  const float vw0 = cw_[0], vw1 = cw_[768], vw2 = cw_[1536], vwb = cb_[0];
  const float aw0 = cw_[256], aw1 = cw_[768 + 256], aw2 = cw_[1536 + 256], awb = cb_[256];
  const float gw0 = cw_[512], gw1 = cw_[768 + 512], gw2 = cw_[1536 + 512], gwb = cb_[512];
  {
    const float* pn = (const float*)(p.ws + OFF_PN) + (size_t)layer * 256 * 512;
    float v0 = pn[(size_t)tid * 512 + c], v1 = pn[(size_t)tid * 512 + 256 + c];
    v0 = wave_sum(v0); v1 = wave_sum(v1);
    if (lane == 0) { red[wave] = v0; red[4 + wave] = v1; }
  }
  {
    bf16_t* zw = sZ + wave * ZROW;
    for (int i = lane; i < 32 * ZB / 8; i += 64) {
      *(uint4*)(zw + i * 8) = make_uint4(0, 0, 0, 0);
      *(uint4*)(zw + 160 * ZB + i * 8) = make_uint4(0, 0, 0, 0);
    }
    const bf16_t* vsrc = HT + (((size_t)0 * NB + bh * 4 + wave) * 256 + c) * SEQ;
    uint4 wv[8]; bf16_t wm[8], wp[8];
#pragma unroll
    for (int jj = 0; jj < 8; ++jj) {
      const int j = lane + 64 * jj;
      wv[jj] = *(const uint4*)(vsrc + j * 8);
      wm[jj] = vsrc[j > 0 ? j * 8 - 1 : 0];
      wp[jj] = vsrc[j < 511 ? j * 8 + 8 : SEQ - 1];
    }
#pragma unroll
    for (int jj = 0; jj < 8; ++jj) {
      const int j = lane + 64 * jj;
      const unsigned pw[4] = {wv[jj].x, wv[jj].y, wv[jj].z, wv[jj].w};
      float e[10];
      e[0] = j > 0 ? bf2f(wm[jj]) : 0.f;
      e[9] = j < 511 ? bf2f(wp[jj]) : 0.f;
#pragma unroll
      for (int k = 0; k < 8; ++k) e[k + 1] = bf2f((bf16_t)((pw[k >> 1] >> ((k & 1) * 16)) & 0xffff));
      float o[8];
#pragma unroll
      for (int k = 0; k < 8; ++k) o[k] = e[k] * vw0 + e[k + 1] * vw1 + e[k + 2] * vw2 + vwb;
      uint4 w; w.x = pack2(o[0], o[1]); w.y = pack2(o[2], o[3]); w.z = pack2(o[4], o[5]); w.w = pack2(o[6], o[7]);
      *(uint4*)(zw + ((j >> 2) + 32) * ZB + (j & 3) * 8) = w;
    }
  }
  const bf16_t* kr = (const bf16_t*)(p.ws + OFF_KREV) + ((size_t)(layer * 2 + 0) * 256 + c) * 8192;
  for (int i = tid; i < 1024; i += 256) *(uint4*)(sK + i * 8) = *(const uint4*)(kr + i * 8);
  __syncthreads();
  const float inv0 = 1.0f / (red[0] + red[1] + red[2] + red[3]);
  const float inv1 = 1.0f / (red[4] + red[5] + red[6] + red[7]);
  const float bias0 = p.hy_bias[(layer * 2 + 0) * 256 + c], bias1 = p.hy_bias[(layer * 2 + 1) * 256 + c];
  f32x16 acc[4];
  const int q = __builtin_amdgcn_readfirstlane(wave), n = lane & 31, h = lane >> 5;
  const int i = 32 * q + n;
  hyena_conv(sK, sZ, acc, q, lane);
  __syncthreads();
  kr = (const bf16_t*)(p.ws + OFF_KREV) + ((size_t)(layer * 2 + 1) * 256 + c) * 8192;
  for (int ii = tid; ii < 1024; ii += 256) *(uint4*)(sK + ii * 8) = *(const uint4*)(kr + ii * 8);
#pragma unroll
  for (int bb = 0; bb < 4; ++bb) {
    const bf16_t* x1 = HT + (((size_t)1 * NB + bh * 4 + bb) * 256 + c) * SEQ;
    bf16_t* zw = sZ + bb * ZROW;
#pragma unroll
    for (int g = 0; g < 4; ++g) {
      const int off = 8 * g + 4 * h;
      float xa[4];
      hy_conv4(hy_raw4(x1, i * 32 + off), i * 32 + off, aw0, aw1, aw2, awb, xa);
      uint2* zp = (uint2*)(zw + (i + 32) * ZB + off);
      uint2 vv = *zp;
      float z0 = xa[0] * (acc[bb][4 * g + 0] * inv0 + bf2f((bf16_t)(vv.x & 0xffff)) * bias0);
      float z1 = xa[1] * (acc[bb][4 * g + 1] * inv0 + bf2f((bf16_t)(vv.x >> 16)) * bias0);
      float z2 = xa[2] * (acc[bb][4 * g + 2] * inv0 + bf2f((bf16_t)(vv.y & 0xffff)) * bias0);
      float z3 = xa[3] * (acc[bb][4 * g + 3] * inv0 + bf2f((bf16_t)(vv.y >> 16)) * bias0);
      uint2 o; o.x = pack2(z0, z1); o.y = pack2(z2, z3);
      *zp = o;
    }
  }
  __syncthreads();
  hyena_conv(sK, sZ, acc, q, lane);
#pragma unroll
  for (int bb = 0; bb < 4; ++bb) {
    const int b = bh * 4 + bb;
    const bf16_t* x2 = HT + (((size_t)2 * NB + b) * 256 + c) * SEQ;
    const bf16_t* zw = sZ + bb * ZROW;
    bf16_t* YT = (bf16_t*)(p.ws + OFF_H + (4u << 20)) + ((size_t)b * 256 + c) * SEQ;
    HyRaw4 xq[4];
#pragma unroll
    for (int g = 0; g < 4; ++g) xq[g] = hy_raw4(x2, i * 32 + 8 * g + 4 * h);
#pragma unroll
    for (int g = 0; g < 4; ++g) {
      const int off = 8 * g + 4 * h;
      float xg[4];
      hy_conv4(xq[g], i * 32 + off, gw0, gw1, gw2, gwb, xg);
      uint2 vv = *(const uint2*)(zw + (i + 32) * ZB + off);
      float y0 = xg[0] * (acc[bb][4 * g + 0] * inv1 + bf2f((bf16_t)(vv.x & 0xffff)) * bias1);
      float y1 = xg[1] * (acc[bb][4 * g + 1] * inv1 + bf2f((bf16_t)(vv.x >> 16)) * bias1);
      float y2 = xg[2] * (acc[bb][4 * g + 2] * inv1 + bf2f((bf16_t)(vv.y & 0xffff)) * bias1);
      float y3 = xg[3] * (acc[bb][4 * g + 3] * inv1 + bf2f((bf16_t)(vv.y >> 16)) * bias1);
      uint2 o; o.x = pack2(y0, y1); o.y = pack2(y2, y3);
      *(uint2*)(YT + i * 32 + off) = o;
    }
  }
  __syncthreads();
}

DI void hyena_ctx_item(const Params& p, int layer, int b, int c, char* smem) {
  float* kf = (float*)smem;
  float* z = kf + 512;
  float* red = z + 256;
  const int tid = get_tid(), lane = tid & 63, wave = tid >> 6;
  const bf16_t* U = (const bf16_t*)(p.ws + OFF_U);
  const float* cw = p.hy_conv_w + (size_t)layer * 3 * 768;
  const float* cb = p.hy_conv_b + layer * 768;
  const int t = tid;
  const size_t rbase = (size_t)(NLAT + b * CTX + t) * INP;
  float hv[3];
#pragma unroll
  for (int w = 0; w < 3; ++w) {
    int ch = w * 256 + c;
    float xc = bf2f(U[rbase + ch]);
    float xp = bf2f(U[rbase - (t > 0 ? INP : 0) + ch]);
    float xn = bf2f(U[rbase + (t < CTX - 1 ? INP : 0) + ch]);
    if (t == 0) xp = 0.f;
    if (t == CTX - 1) xn = 0.f;
    hv[w] = xp * cw[ch] + xc * cw[768 + ch] + xn * cw[1536 + ch] + cb[ch];
  }
  {
    const float* pn = (const float*)(p.ws + OFF_PNC);
    float v0 = tid < 16 ? pn[tid * 512 + c] : 0.f, v1 = tid < 16 ? pn[tid * 512 + 256 + c] : 0.f;
    v0 = wave_sum(v0); v1 = wave_sum(v1);
    if (tid == 0) { red[0] = v0; red[1] = v1; }
  }
  float y = 0.f, zin = hv[0];
#pragma unroll
  for (int o = 0; o < 2; ++o) {
    const float* kr = (const float*)(p.ws + OFF_KREVC) + ((size_t)o * 256 + c) * 512;
    __syncthreads();
    kf[tid] = kr[tid]; kf[256 + tid] = kr[256 + tid];
    z[tid] = zin;
    __syncthreads();
    float a = 0.f;
    for (int s = 0; s < CTX; ++s) a += kf[CTX - 1 - t + s] * z[s];
    const float inv = 1.0f / red[o];
    const float bias = p.hy_bias[(layer * 2 + o) * 256 + c];
    y = hv[1 + o] * (a * inv + zin * bias);
    zin = y;
  }
  bf16_t* MIXC = (bf16_t*)(p.ws + OFF_U) + (size_t)NLAT * D;
  MIXC[(size_t)(b * CTX + t) * D + c] = f2bf(y);
  __syncthreads();
}

template <int DQK>
DI void attn_item(const bf16_t* __restrict__ Q, const bf16_t* __restrict__ Kp, const bf16_t* __restrict__ Vt, int q0, int nkeys,
                  bf16_t* __restrict__ mix, int colbase, int b, char* smem) {
  constexpr int KROW = DQK + 8, NSTEP = DQK / 16, KCH = DQK / 8;
  constexpr bool K3 = (DQK == 96);
  constexpr int VROW = 68;
  bf16_t* sK = (bf16_t*)smem;
  bf16_t* sV = sK + 2 * 64 * KROW;
  const int tid = get_tid(), lane = tid & 63, wave = tid >> 6, r = lane & 31, h = lane >> 5;
  bf16x8 qf[NSTEP];
  {
    const bf16_t* qr = Q + (size_t)(q0 + wave * 32 + r) * DQK + 8 * h;
#pragma unroll
    for (int s = 0; s < NSTEP; ++s) qf[s] = *(const bf16x8*)(qr + 16 * s);
  }
  const int kid0 = tid, kid1 = tid + 256, kid2 = tid + 512;
  const int kgo0 = (kid0 / KCH) * DQK + (kid0 % KCH) * 8, kgo1 = (kid1 / KCH) * DQK + (kid1 % KCH) * 8, kgo2 = (kid2 / KCH) * DQK + (kid2 % KCH) * 8;
  const int kso0 = (kid0 / KCH) * KROW + (kid0 % KCH) * 8, kso1 = (kid1 / KCH) * KROW + (kid1 % KCH) * 8, kso2 = (kid2 / KCH) * KROW + (kid2 % KCH) * 8;
  const int vrow0 = tid >> 3, vcc = (tid & 7) * 8;
  const bf16_t* Vg0 = Vt + (size_t)vrow0 * NKEY + vcc;
  const bf16_t* Vg1 = Vt + (size_t)(vrow0 + 32) * NKEY + vcc;
  const int vso0 = vrow0 * VROW + vcc, vso1 = (vrow0 + 32) * VROW + vcc;
  uint4 pk0, pk1, pk2, pv0, pv1, qk0, qk1, qk2, qv0, qv1;
  pk2 = make_uint4(0, 0, 0, 0); qk2 = pk2;
#define A_LOAD(P, key0_)                                                        \
  {                                                                             \
    const bf16_t* kb_ = Kp + (size_t)(key0_) * DQK;                             \
    P##k0 = *(const uint4*)(kb_ + kgo0);                                        \
    P##k1 = *(const uint4*)(kb_ + kgo1);                                        \
    if (K3) P##k2 = *(const uint4*)(kb_ + kgo2);                                \
    P##v0 = *(const uint4*)(Vg0 + (key0_));                                     \
    P##v1 = *(const uint4*)(Vg1 + (key0_));                                     \
  }
#define A_WRITE(P, buf_)                                                        \
  {                                                                             \
    bf16_t* kw_ = sK + (buf_) * 64 * KROW;                                      \
    bf16_t* vw_ = sV + (buf_) * 64 * VROW;                                      \
    *(uint4*)(kw_ + kso0) = P##k0;                                              \
    *(uint4*)(kw_ + kso1) = P##k1;                                              \
    if (K3) *(uint4*)(kw_ + kso2) = P##k2;                                      \
    ((uint2*)(vw_ + vso0))[0] = make_uint2(P##v0.x, P##v0.y);                   \
    ((uint2*)(vw_ + vso0))[1] = make_uint2(P##v0.z, P##v0.w);                   \
    ((uint2*)(vw_ + vso1))[0] = make_uint2(P##v1.x, P##v1.y);                   \
    ((uint2*)(vw_ + vso1))[1] = make_uint2(P##v1.z, P##v1.w);                   \
  }
  f32x16 o0, o1;
#pragma unroll
  for (int i = 0; i < 16; ++i) { o0[i] = 0.f; o1[i] = 0.f; }
  float m = -1e30f, l = 0.f;
#define A_TILE(buf_)                                                            \
  {                                                                             \
    const bf16_t* kb = sK + (buf_) * 64 * KROW + r * KROW + 8 * h;              \
    f32x16 s0, s1;                                                              \
    _Pragma("unroll") for (int i = 0; i < 16; ++i) { s0[i] = 0.f; s1[i] = 0.f; } \
    __builtin_amdgcn_s_setprio(1);                                              \
    _Pragma("unroll") for (int s = 0; s < NSTEP; ++s) {                         \
      bf16x8 k0 = *(const bf16x8*)(kb + 16 * s);                                \
      bf16x8 k1 = *(const bf16x8*)(kb + 32 * KROW + 16 * s);                    \
      s0 = MFMA32(k0, qf[s], s0);                                               \
      s1 = MFMA32(k1, qf[s], s1);                                               \
    }                                                                           \
    __builtin_amdgcn_s_setprio(0);                                              \
    float mxa = fmaxf(s0[0], s1[0]), mxb = fmaxf(s0[1], s1[1]), mxc = fmaxf(s0[2], s1[2]), mxd = fmaxf(s0[3], s1[3]); \
    _Pragma("unroll") for (int i = 4; i < 16; i += 4) {                         \
      mxa = fmaxf(fmaxf(mxa, s0[i]), s1[i]); mxb = fmaxf(fmaxf(mxb, s0[i + 1]), s1[i + 1]); \
      mxc = fmaxf(fmaxf(mxc, s0[i + 2]), s1[i + 2]); mxd = fmaxf(fmaxf(mxd, s0[i + 3]), s1[i + 3]); \
    }                                                                           \
    float mx = fmaxf(fmaxf(mxa, mxb), fmaxf(mxc, mxd));                         \
    mx = xhalf_max(mx);                                                         \
    if (__builtin_amdgcn_ballot_w64(mx > m + 8.0f) != 0ull) {                   \
      const float mn = fmaxf(m, mx);                                            \
      const float alpha = __builtin_amdgcn_exp2f(m - mn);                       \
      m = mn;                                                                   \
      l *= alpha;                                                               \
      _Pragma("unroll") for (int i = 0; i < 16; ++i) { o0[i] *= alpha; o1[i] *= alpha; } \
    }                                                                           \
    float ls = 0.f;                                                             \
    _Pragma("unroll") for (int i = 0; i < 16; ++i) { s0[i] = __builtin_amdgcn_exp2f(s0[i] - m); ls += s0[i]; } \
    _Pragma("unroll") for (int i = 0; i < 16; ++i) { s1[i] = __builtin_amdgcn_exp2f(s1[i] - m); ls += s1[i]; } \
    l += ls;                                                                    \
    const bf16_t* vb = sV + (buf_) * 64 * VROW + r * VROW + 4 * h;              \
    __builtin_amdgcn_s_setprio(1);                                              \
    _Pragma("unroll") for (int t = 0; t < 2; ++t)                               \
      _Pragma("unroll") for (int s = 0; s < 2; ++s) {                           \
        bf16x8 pbv;                                                             \
        if (t == 0) pbv = pack8(s0[8 * s + 0], s0[8 * s + 1], s0[8 * s + 2], s0[8 * s + 3], s0[8 * s + 4], s0[8 * s + 5], s0[8 * s + 6], s0[8 * s + 7]); \
        else pbv = pack8(s1[8 * s + 0], s1[8 * s + 1], s1[8 * s + 2], s1[8 * s + 3], s1[8 * s + 4], s1[8 * s + 5], s1[8 * s + 6], s1[8 * s + 7]); \
        const int koff = 32 * t + 16 * s;                                       \
        const uint2 va0 = *(const uint2*)(vb + koff), va1 = *(const uint2*)(vb + koff + 8); \
        const uint2 vc0 = *(const uint2*)(vb + 32 * VROW + koff), vc1 = *(const uint2*)(vb + 32 * VROW + koff + 8); \
        const bf16x8 vav = __builtin_bit_cast(bf16x8, make_uint4(va0.x, va0.y, va1.x, va1.y)); \
        const bf16x8 vcv = __builtin_bit_cast(bf16x8, make_uint4(vc0.x, vc0.y, vc1.x, vc1.y)); \
        o0 = MFMA32(vav, pbv, o0);                                              \
        o1 = MFMA32(vcv, pbv, o1);                                              \
      }                                                                         \
    __builtin_amdgcn_s_setprio(0);                                              \
  }
  const int nt = nkeys >> 6;
  A_LOAD(p, 0)
  A_LOAD(q, 64)
  A_WRITE(p, 0)
  __syncthreads();
  if (nt > 2) A_LOAD(p, 128)
  for (int kt = 0; kt < nt; kt += 2) {
    A_TILE(0)
    A_WRITE(q, 1)
    __syncthreads();
    if (kt + 3 < nt) A_LOAD(q, (kt + 3) << 6)
    A_TILE(1)
    if (kt + 2 < nt) A_WRITE(p, 0)
    __syncthreads();
    if (kt + 4 < nt) A_LOAD(p, (kt + 4) << 6)
  }
#undef A_LOAD
#undef A_WRITE
#undef A_TILE
  l = xhalf_sum(l);
  const float inv = 1.0f / l;
  const int kp = q0 + wave * 32 + r;
  bf16_t* orow = mix + (size_t)row_of(b, kp) * D + colbase;
#pragma unroll
  for (int g = 0; g < 4; ++g) {
    uint2 w0, w1;
    w0.x = pack2(o0[4 * g] * inv, o0[4 * g + 1] * inv); w0.y = pack2(o0[4 * g + 2] * inv, o0[4 * g + 3] * inv);
    w1.x = pack2(o1[4 * g] * inv, o1[4 * g + 1] * inv); w1.y = pack2(o1[4 * g + 2] * inv, o1[4 * g + 3] * inv);
    *(uint2*)(orow + 8 * g + 4 * h) = w0;
    *(uint2*)(orow + 32 + 8 * g + 4 * h) = w1;
  }
}

DI void ytrans_loop(const Params& p, char* smem) {
  bf16_t* sT = (bf16_t*)smem;
  const int tid = get_tid();
  int it = blockIdx.x;
  if (it >= 2048) return;
  const int cc0 = tid >> 3, t8 = tid & 7;
  uint4 w0, w1, n0, n1;
#define YT_LOAD(it_, A0, A1)                                                                              \
  {                                                                                                       \
    const int b_ = (it_) >> 8, tt0_ = (((it_) >> 2) & 63) * 64, c0_ = ((it_) & 3) * 64;                   \
    const bf16_t* YT_ = (const bf16_t*)(p.ws + OFF_H + (4u << 20)) + ((size_t)b_ * 256 + c0_) * SEQ + tt0_; \
    A0 = *(const uint4*)(YT_ + (size_t)cc0 * SEQ + t8 * 8);                                               \
    A1 = *(const uint4*)(YT_ + (size_t)(cc0 + 32) * SEQ + t8 * 8);                                        \
  }
  YT_LOAD(it, w0, w1)
  for (;;) {
    const int itn = it + gridDim.x;
    const bool has = itn < 2048;
    if (has) YT_LOAD(itn, n0, n1)
    {
      const unsigned pa[4] = {w0.x, w0.y, w0.z, w0.w}, pb[4] = {w1.x, w1.y, w1.z, w1.w};
#pragma unroll
      for (int e = 0; e < 8; ++e) {
        sT[(t8 * 8 + e) * 66 + cc0] = (bf16_t)((pa[e >> 1] >> ((e & 1) * 16)) & 0xffff);
        sT[(t8 * 8 + e) * 66 + cc0 + 32] = (bf16_t)((pb[e >> 1] >> ((e & 1) * 16)) & 0xffff);
      }
    }
    __syncthreads();
    {
      const int b = it >> 8, tt0 = ((it >> 2) & 63) * 64, c0 = (it & 3) * 64;
      bf16_t* MIX = (bf16_t*)(p.ws + OFF_U) + ((size_t)b * SEQ + tt0) * D + c0;
#pragma unroll
      for (int i = 0; i < 2; ++i) {
        int id = tid + 256 * i, tt = id >> 3, c8 = id & 7;
        const unsigned* sp = (const unsigned*)(sT + tt * 66 + c8 * 8);
        uint4 w; w.x = sp[0]; w.y = sp[1]; w.z = sp[2]; w.w = sp[3];
        *(uint4*)(MIX + (size_t)tt * D + c8 * 8) = w;
      }
    }
    __syncthreads();
    if (!has) break;
    it = itn; w0 = n0; w1 = n1;
  }
#undef YT_LOAD
}

DI void attn_dispatch(const Params& p, int type, int b, int hd, int qb, char* smem) {
  bf16_t* MIX = (bf16_t*)(p.ws + OFF_U);
  const int nkeys = qb < 2 ? CTX : NKEY;
  if (type == 0) {
    const bf16_t* Q = (const bf16_t*)(p.ws + OFF_QG) + (size_t)(b * 6 + hd) * NKEY * 64;
    const bf16_t* K = (const bf16_t*)(p.ws + OFF_KG) + (size_t)(b * 2 + hd / 3) * NKEY * 64;
    const bf16_t* V = (const bf16_t*)(p.ws + OFF_VGT) + (size_t)(b * 2 + hd / 3) * 64 * NKEY;
    attn_item<64>(Q, K, V, qb * 128, nkeys, MIX, 256 + hd * 64, b, smem);
  } else {
    const bf16_t* Q = (const bf16_t*)(p.ws + OFF_QM) + (size_t)(b * 6 + hd) * NKEY * 96;
    const bf16_t* K = (const bf16_t*)(p.ws + OFF_KM) + (size_t)(b * 6 + hd) * NKEY * 96;
    const bf16_t* V = (const bf16_t*)(p.ws + OFF_VMT) + (size_t)(b * 6 + hd) * 64 * NKEY;
    attn_item<96>(Q, K, V, qb * 128, nkeys, MIX, 640 + hd * 64, b, smem);
  }
}

DI void phase_attn(const Params& p, int layer, char* smem) {
  const int n_lat = 96 * 32, n_ctx = (layer == 0) ? 96 * 2 : 0;
  for (int it = blockIdx.x; it < n_lat + n_ctx; it += gridDim.x) {
    int combo, qb;
    if (it < n_lat) { int xc = it & 7, j = it >> 3; combo = (j >> 5) * 8 + xc; qb = 2 + (j & 31); }
    else { int r = it - n_lat; combo = r >> 1; qb = r & 1; }
    const int type = combo / 48, bh = combo % 48;
    attn_dispatch(p, type, bh / 6, bh % 6, qb, smem);
  }
  ytrans_loop(p, smem);
}

DI void phase_mix_a(const Params& p, int layer, char* smem) {
  const bf16_t* wl = (const bf16_t*)(p.ws + OFF_W) + (size_t)layer * WL;
  for (int it = blockIdx.x; it < 512; it += gridDim.x) hyena_item(p, layer, it >> 1, it & 1, smem);
  if (layer == 0)
    for (int it = blockIdx.x; it < NB * 256; it += gridDim.x) hyena_ctx_item(p, layer, it >> 8, it & 255, smem);
  const int MT = NTOK / 128;
  gemm_phase<EPI_QUP>(p, layer, (const bf16_t*)(p.ws + OFF_MQN), 256, wl + W_UQ, 256, 256, (layer == 0) ? MT : NLAT / 128, 5, smem);
  gemm_phase<EPI_KVUP>(p, layer, (const bf16_t*)(p.ws + OFF_MKVN), 128, wl + W_UKV, 128, 128, MT, 6, smem, true);
}

#define XB_TMO      128
#define XB_XCNT(j)  (256  + 64 * (j))
#define XB_XSUB(j)  (1280 + 64 * (j))
#define XB_XGEN(j)  (2304 + 64 * (j))
#define XB_TOP      3328
#define XB_TOPGEN   3392
#define XCD_BAR_WORDS 3456
#define XB_SPIN_CAP (1u << 20)
#define LAS __attribute__((address_space(3)))
DI unsigned xb_ld(unsigned* p) { return __hip_atomic_load(p, __ATOMIC_RELAXED, __HIP_MEMORY_SCOPE_AGENT); }
DI unsigned xb_add(unsigned* p, unsigned v) { return __hip_atomic_fetch_add(p, v, __ATOMIC_RELAXED, __HIP_MEMORY_SCOPE_AGENT); }
DI unsigned xb_xcc_id() { return (unsigned)__builtin_amdgcn_s_getreg((3 << 11) | 20) & 0xFu; }
#define XB_SPIN(cond, bar) do { unsigned _sp = 0; while (cond) { __builtin_amdgcn_s_sleep(1); \
    if ((++_sp & 255u) == 0u) { if (xb_ld(&(bar)[XB_TMO])) break; if (_sp > XB_SPIN_CAP) { atomicAdd(&(bar)[XB_TMO], 1u); break; } } } } while (0)
struct XcdBarrier { unsigned* bar; unsigned x; volatile LAS unsigned* st; };
DI XcdBarrier xcd_barrier_post(unsigned* bar, volatile LAS unsigned* st) {
  XcdBarrier b; b.bar = bar; b.x = xb_xcc_id(); b.st = st;
  if (threadIdx.x == 0) (void)xb_add(&bar[XB_XCNT(b.x)], 1u);
  return b;
}
DI void xcd_barrier_complete(unsigned* bar, unsigned x, unsigned& nloc, unsigned& nx) {
  const unsigned G = gridDim.x * gridDim.y * gridDim.z;
  unsigned sum, cnt, mine, sp = 0u;
  for (;;) {
    sum = 0u; cnt = 0u; mine = 0u;
#pragma unroll
    for (unsigned j = 0; j < 16; ++j) { const unsigned c = xb_ld(&bar[XB_XCNT(j)]); sum += c; cnt += (c > 0u) ? 1u : 0u; mine = (j == x) ? c : mine; }
    if (sum == G) break;
    __builtin_amdgcn_s_sleep(1);
    if ((++sp & 255u) == 0u) { if (xb_ld(&bar[XB_TMO])) break; if (sp > XB_SPIN_CAP) { atomicAdd(&bar[XB_TMO], 1u); break; } }
  }
  nloc = mine > 0u ? mine : 1u; nx = cnt > 0u ? cnt : 1u;
}
DI void xcd_barrier(const XcdBarrier& b) {
  asm volatile("s_waitcnt vmcnt(0)" ::: "memory");
  __syncthreads();
  if (threadIdx.x == 0) {
    unsigned* bar = b.bar;
    __builtin_amdgcn_s_waitcnt(0);
    unsigned nloc = b.st[0], nx = b.st[1];
    if (nloc == 0u) { xcd_barrier_complete(bar, b.x, nloc, nx); b.st[0] = nloc; b.st[1] = nx; }
    const unsigned old = xb_add(&bar[XB_XSUB(b.x)], 1u);
    const unsigned gen = old / nloc;
    if (old + 1u == (gen + 1u) * nloc) {
      __builtin_amdgcn_fence(__ATOMIC_RELEASE, "agent");
      asm volatile("s_waitcnt vmcnt(0)" ::: "memory");
      const unsigned og = xb_add(&bar[XB_TOP], 1u);
      const unsigned tg = og / nx;
      if (og + 1u == (tg + 1u) * nx) xb_add(&bar[XB_TOPGEN], 1u);
      else XB_SPIN(xb_ld(&bar[XB_TOPGEN]) == tg, bar);
      __builtin_amdgcn_fence(__ATOMIC_ACQUIRE, "agent");
      xb_add(&bar[XB_XGEN(b.x)], 1u);
      asm volatile("s_waitcnt vmcnt(0)" ::: "memory");
    } else {
      XB_SPIN(xb_ld(&bar[XB_XGEN(b.x)]) == gen, bar);
      __builtin_amdgcn_fence(__ATOMIC_ACQUIRE, "agent");
      asm volatile("s_waitcnt vmcnt(0)" ::: "memory");
    }
  }
  __syncthreads();
}

DI void flat_barrier(unsigned* cnt, unsigned& gen) {
  asm volatile("s_waitcnt vmcnt(0)" ::: "memory");
  __syncthreads();
  if (threadIdx.x == 0) {
    __builtin_amdgcn_fence(__ATOMIC_RELEASE, "agent");
    asm volatile("s_waitcnt vmcnt(0)" ::: "memory");
    xb_add(cnt, 1u);
    const unsigned target = (gen + 1u) * gridDim.x;
    unsigned sp = 0;
    while (xb_ld(cnt) < target) { __builtin_amdgcn_s_sleep(1); if (++sp > (1u << 22)) break; }
    __builtin_amdgcn_fence(__ATOMIC_ACQUIRE, "agent");
    asm volatile("s_waitcnt vmcnt(0)" ::: "memory");
  }
  gen += 1u;
  __syncthreads();
}

__global__ void __launch_bounds__(THREADS, 2) fwd_megakernel(Params p) {
  __shared__ __attribute__((aligned(16))) char smem[79872];
  cg::grid_group grid = cg::this_grid();
  volatile LAS unsigned* xst = (volatile LAS unsigned*)(smem + 79856);
  if (threadIdx.x == 0) { xst[0] = 0u; xst[1] = 0u; }
  __syncthreads();
  if (p.ws == nullptr) grid.sync();
  const XcdBarrier xb = xcd_barrier_post((unsigned*)(p.ws + OFF_BAR), xst);
  phase_prologue(p, smem);
  xcd_barrier(xb);
  phase_modfinal(p);
  xcd_barrier(xb);
  for (int layer = 0; layer < 2; ++layer) {
    const bf16_t* wl = (const bf16_t*)(p.ws + OFF_W) + (size_t)layer * WL;
    const int MT_ALL = NTOK / 128, MT_LAT = NLAT / 128;
    const int MT_RES = (layer == 0) ? MT_ALL : MT_LAT;
    phase_norm(p, layer, 0, NTOK);
    xcd_barrier(xb);
    gemm_phase<EPI_U>(p, layer, (const bf16_t*)(p.ws + OFF_H), D, wl + W_IN, D, D, MT_ALL, INP / 128, smem);
    xcd_barrier(xb);
    phase_prep(p, layer, smem);
    xcd_barrier(xb);
    phase_mix_a(p, layer, smem);
    xcd_barrier(xb);
    phase_attn(p, layer, smem);
    xcd_barrier(xb);
    gemm_phase<EPI_RES1>(p, layer, (const bf16_t*)(p.ws + OFF_U), D, wl + W_OUT, D, D, MT_RES, D / 128, smem);
    xcd_barrier(xb);
    phase_norm(p, layer, 1, MT_RES * 128);
    xcd_barrier(xb);
    gemm_phase<EPI_SWIGLU>(p, layer, (const bf16_t*)(p.ws + OFF_H), D, wl + W_13, D, D, MT_RES, 2 * FFH / 128, smem);
    xcd_barrier(xb);
    gemm_phase<EPI_RES2>(p, layer, (const bf16_t*)(p.ws + OFF_U), FFH, wl + W_2, FFH, FFH, MT_RES, D / 128, smem);
    xcd_barrier(xb);
  }
  phase_final(p);
}

extern "C" void kernel_launch(void* const* d_in, const int* in_sizes, int n_in, void* d_out, int out_size, void* d_ws, size_t ws_size,
                              hipStream_t stream) {
  static int grid_blocks = 0;
  if (!grid_blocks) {
    int dev = 0, cus = 0, per_cu = 0;
    hipGetDevice(&dev);
    hipDeviceGetAttribute(&cus, hipDeviceAttributeMultiprocessorCount, dev);
    hipOccupancyMaxActiveBlocksPerMultiprocessor(&per_cu, fwd_megakernel, THREADS, 0);
    if (per_cu > 2) per_cu = 2;
    if (per_cu < 1) per_cu = 1;
    grid_blocks = cus * per_cu;
  }
  if (ws_size < WS_NEED) { fprintf(stderr, "workspace too small: %zu < %zu\n", ws_size, (size_t)WS_NEED); return; }
  Params p{};
  const float** f = (const float**)&p;
  for (int i = 0; i < 29; ++i) f[i] = (const float*)d_in[i];
  p.out = (float*)d_out;
  p.ws = (char*)d_ws;
  void* args[] = {&p};
  (void)hipMemsetAsync((char*)d_ws + OFF_BAR, 0, XCD_BAR_WORDS * 4, stream);
  hipError_t e = hipLaunchCooperativeKernel((void*)fwd_megakernel, dim3(grid_blocks), dim3(THREADS), args, 0, stream);
  if (e != hipSuccess) fprintf(stderr, "cooperative launch failed: %s (grid %d)\n", hipGetErrorString(e), grid_blocks);
}
#ifdef PHASE_TEST
#define TK(name, body) __global__ void __launch_bounds__(THREADS, 2) name(Params p) { __shared__ __attribute__((aligned(16))) char smem[79872]; body; }
TK(t_prologue, phase_prologue(p, smem))
TK(t_norm, phase_norm(p, 1, 0, NTOK))
TK(t_gemm_u, gemm_phase<EPI_U>(p, 1, (const bf16_t*)(p.ws + OFF_H), D, (const bf16_t*)(p.ws + OFF_W), D, D, 272, 15, smem))
TK(t_gemm_res1, gemm_phase<EPI_RES1>(p, 1, (const bf16_t*)(p.ws + OFF_H), D, (const bf16_t*)(p.ws + OFF_W), D, D, 272, 8, smem))
TK(t_gemm_swiglu, gemm_phase<EPI_SWIGLU>(p, 1, (const bf16_t*)(p.ws + OFF_H), D, (const bf16_t*)(p.ws + OFF_W), D, D, 272, 44, smem))
TK(t_gemm_qup, gemm_phase<EPI_QUP>(p, 1, (const bf16_t*)(p.ws + OFF_H), 256, (const bf16_t*)(p.ws + OFF_W), 256, 256, 272, 5, smem))
TK(t_gemm_kvup, gemm_phase<EPI_KVUP>(p, 1, (const bf16_t*)(p.ws + OFF_H), 128, (const bf16_t*)(p.ws + OFF_W), 128, 128, 272, 6, smem))
TK(t_prep, phase_prep(p, 1, smem))
TK(t_hyena, hyena_item(p, 1, blockIdx.x >> 1, blockIdx.x & 1, smem))
TK(t_hyena_ctx, hyena_ctx_item(p, 0, blockIdx.x >> 8, blockIdx.x & 255, smem))
TK(t_attn, phase_attn(p, 0, smem))
TK(t_final, phase_final(p))
#endif
```

```cpp
#include <hip/hip_runtime.h>
#include <hip/hip_cooperative_groups.h>
#include <cstdio>
#include <cstdint>
namespace cg = cooperative_groups;

#define DI __device__ __forceinline__
typedef unsigned short bf16_t;
typedef short bf16x8 __attribute__((ext_vector_type(8)));
typedef float f32x16 __attribute__((ext_vector_type(16)));
#define MFMA32(a, b, c) __builtin_amdgcn_mfma_f32_32x32x16_bf16((a), (b), (c), 0, 0, 0)

constexpr int D = 1024, NB = 8, SEQ = 4096, CTX = 256, NLAT = NB * SEQ, NCTXR = NB * CTX, NTOK = NLAT + NCTXR;
constexpr int NKEY = CTX + SEQ;
constexpr int INW = 1824, INP = 1920, FFH = 2816;
constexpr int THREADS = 256;
constexpr int XCD_BAR_WORDS_C = 3456;
constexpr float LOG2E = 1.4426950408889634f;

constexpr size_t SZ_U = (size_t)NTOK * INP * 2;
constexpr size_t OFF_U = 0;
constexpr size_t OFF_QG = OFF_U + SZ_U;
constexpr size_t OFF_KG = OFF_QG + (size_t)NB * 6 * NKEY * 64 * 2;
constexpr size_t OFF_VGT = OFF_KG + (size_t)NB * 2 * NKEY * 64 * 2;
constexpr size_t OFF_QM = OFF_VGT + (size_t)NB * 2 * NKEY * 64 * 2;
constexpr size_t OFF_KM = OFF_QM + (size_t)NB * 6 * NKEY * 96 * 2;
constexpr size_t OFF_VMT = OFF_KM + (size_t)NB * 6 * NKEY * 96 * 2;
constexpr size_t OFF_MQN = OFF_VMT + (size_t)NB * 6 * NKEY * 64 * 2;
constexpr size_t OFF_MKVN = OFF_MQN + (size_t)NTOK * 256 * 2;
constexpr size_t OFF_HT = OFF_MKVN + (size_t)NTOK * 128 * 2;
constexpr size_t OFF_H = OFF_HT + (size_t)3 * NB * 256 * SEQ * 2;
constexpr size_t OFF_XCTX = OFF_H + (size_t)NTOK * D * 2;
constexpr size_t OFF_W = OFF_XCTX + (size_t)NCTXR * D * 4;
constexpr size_t W_IN = 0, W_OUT = W_IN + (size_t)INP * D, W_13 = W_OUT + (size_t)D * D, W_2 = W_13 + (size_t)2 * FFH * D,
                 W_UQ = W_2 + (size_t)D * FFH, W_UKV = W_UQ + (size_t)640 * 256, WL = W_UKV + (size_t)768 * 128;
constexpr size_t OFF_MOD = OFF_W + 2 * WL * 2;
constexpr size_t OFF_MODP = OFF_MOD + (size_t)2 * 9 * 6144 * 4;
constexpr size_t OFF_KREV = OFF_MODP + (size_t)2 * 8 * 9 * 6144 * 4;
constexpr size_t OFF_KREVC = OFF_KREV + (size_t)2 * 2 * 256 * 8192 * 2;
constexpr size_t OFF_PN = OFF_KREVC + (size_t)2 * 256 * 512 * 4;
constexpr size_t OFF_PNC = OFF_PN + (size_t)2 * 256 * 512 * 4;
constexpr size_t OFF_ROPEG = OFF_PNC + (size_t)16 * 512 * 4;
constexpr size_t OFF_ROPEM = OFF_ROPEG + (size_t)64 * 16 * 8;
constexpr size_t OFF_BAR = OFF_ROPEM + (size_t)64 * 8 * 8;
constexpr size_t WS_NEED = OFF_BAR + (size_t)XCD_BAR_WORDS_C * 4;

struct Params {
  const float *x, *c, *ctx, *c_ctx, *mod_w, *mod_b, *norm1_g, *norm2_g, *w_in, *hy_conv_w, *hy_conv_b, *hy_filt_w1, *hy_filt_b1,
      *hy_filt_w2, *hy_filt_b2, *hy_filt_w3, *hy_filt_freq, *hy_bias, *gqa_q_g, *gqa_k_g, *mla_q_g, *mla_kv_g, *mla_w_uq, *mla_w_ukv,
      *w_out, *ffn_w1, *ffn_w3, *ffn_w2, *final_g;
  float* out;
  char* ws;
};

typedef float f32x2_t __attribute__((ext_vector_type(2)));
typedef __bf16 bf16x2_t __attribute__((ext_vector_type(2)));
typedef unsigned u32x4 __attribute__((ext_vector_type(4)));
DI unsigned pack2(float lo, float hi) { f32x2_t v = {lo, hi}; bf16x2_t r = __builtin_convertvector(v, bf16x2_t); return __builtin_bit_cast(unsigned, r); }
DI bf16_t f2bf(float x) { return (bf16_t)(pack2(x, x) & 0xffffu); }
DI float bf2f(bf16_t v) { return __uint_as_float(((unsigned)v) << 16); }
DI bf16x8 pack8(float a0, float a1, float a2, float a3, float a4, float a5, float a6, float a7) {
  u32x4 p = {pack2(a0, a1), pack2(a2, a3), pack2(a4, a5), pack2(a6, a7)};
  return __builtin_bit_cast(bf16x8, p);
}
DI float wave_sum(float v) {
#pragma unroll
  for (int o = 32; o > 0; o >>= 1) v += __shfl_xor(v, o);
  return v;
}
DI int get_tid() { int t = threadIdx.x; asm volatile("" : "+v"(t)); return t; }
DI float xhalf_max(float x) { auto r = __builtin_amdgcn_permlane32_swap(__float_as_uint(x), __float_as_uint(x), false, false); return fmaxf(__uint_as_float(r[0]), __uint_as_float(r[1])); }
DI float xhalf_sum(float x) { auto r = __builtin_amdgcn_permlane32_swap(__float_as_uint(x), __float_as_uint(x), false, false); return __uint_as_float(r[0]) + __uint_as_float(r[1]); }
DI int crow(int reg, int h) { return (reg & 3) + 8 * (reg >> 2) + 4 * h; }
DI void sincos_acc(float x, float& s, float& c) {
  float k = rintf(x * 0.63661977236758134f);
  int q = (int)k;
  float r = fmaf(k, -1.5707963705062866f, x);
  r = fmaf(k, 4.3711388286737929e-8f, r);
  float r2 = r * r;
  float sp = r + r * r2 * (-1.6666654611e-1f + r2 * (8.3321608736e-3f + r2 * (-1.9515295891e-4f)));
  float cp = 1.0f - 0.5f * r2 + r2 * r2 * (4.166664568298827e-2f + r2 * (-1.388731625493765e-3f + r2 * 2.443315711809948e-5f));
  switch (q & 3) {
    case 0: s = sp; c = cp; break;
    case 1: s = cp; c = -sp; break;
    case 2: s = -sp; c = -cp; break;
    default: s = -cp; c = sp; break;
  }
}
DI float sin_acc(float x) { float s, c; sincos_acc(x, s, c); return s; }
DI float silu_f(float x) { return x * __builtin_amdgcn_rcpf(1.0f + __expf(-x)); }

DI void row_info(int row, int& b, int& kp) {
  if (row < NLAT) { b = row >> 12; kp = CTX + (row & 4095); }
  else { int r = row - NLAT; b = r >> 8; kp = r & 255; }
}
DI int row_of(int b, int kp) { return kp < CTX ? NLAT + b * CTX + kp : b * SEQ + (kp - CTX); }
DI const float* xold_ptr(const Params& p, int layer, bool first, int row) {
  if (row < NLAT) return (first ? p.x : p.out) + (size_t)row * D;
  return (first ? p.ctx : (const float*)(p.ws + OFF_XCTX)) + (size_t)(row - NLAT) * D;
}
DI float* xnew_ptr(const Params& p, int row) {
  if (row < NLAT) return p.out + (size_t)row * D;
  return (float*)(p.ws + OFF_XCTX) + (size_t)(row - NLAT) * D;
}
DI void tile_map(int t, int MT, int NT, int& mt, int& nt) {
  const int xc = t & 7, j = t >> 3, mtx = MT >> 3, full = NT >> 3, per = mtx * 8;
  int sc = j / per, rem, w;
  if (sc < full) { rem = j - sc * per; w = 8; }
  else { sc = full; rem = j - full * per; w = NT & 7; }
  const int m = rem / w, nn = rem - m * w;
  mt = xc * mtx + m; nt = sc * 8 + nn;
}

constexpr int LDT = 72;
enum { EPI_U = 0, EPI_RES1, EPI_SWIGLU, EPI_RES2, EPI_QUP, EPI_KVUP };

template <int EPI>
DI void epilogue(const Params& p, int layer, f32x16 (&acc)[2][2], int mrow0, int ncol0, int lane) {
  const int c = lane & 31, h = lane >> 5;
  if (EPI == EPI_U) {
    if (ncol0 < 768 && mrow0 < NLAT) {
      bf16_t* HT = (bf16_t*)(p.ws + OFF_HT);
#pragma unroll
      for (int ni = 0; ni < 2; ++ni) {
        const int col = ncol0 + ni * 32 + c, which = col >> 8, ch = col & 255;
#pragma unroll
        for (int mi = 0; mi < 2; ++mi)
#pragma unroll
          for (int g = 0; g < 4; ++g) {
            const int row0 = mrow0 + mi * 32 + 8 * g + 4 * h, bq = row0 >> 12, s0 = row0 & 4095;
            uint2 w;
            w.x = pack2(acc[mi][ni][4 * g], acc[mi][ni][4 * g + 1]);
            w.y = pack2(acc[mi][ni][4 * g + 2], acc[mi][ni][4 * g + 3]);
            *(uint2*)(HT + (((size_t)which * NB + bq) * 256 + ch) * SEQ + s0) = w;
          }
      }
    } else if (ncol0 >= 1280 && ncol0 < 1408) {
      bf16_t* Vgt = (bf16_t*)(p.ws + OFF_VGT);
      const int kh = (ncol0 - 1280) >> 6;
#pragma unroll
      for (int ni = 0; ni < 2; ++ni) {
        const int dv = ni * 32 + c;
#pragma unroll
        for (int mi = 0; mi < 2; ++mi)
#pragma unroll
          for (int g = 0; g < 4; ++g) {
            int bq, kp; row_info(mrow0 + mi * 32 + 8 * g + 4 * h, bq, kp);
            uint2 w;
            w.x = pack2(acc[mi][ni][4 * g], acc[mi][ni][4 * g + 1]);
            w.y = pack2(acc[mi][ni][4 * g + 2], acc[mi][ni][4 * g + 3]);
            *(uint2*)(Vgt + ((size_t)(bq * 2 + kh) * 64 + dv) * NKEY + kp) = w;
          }
      }
    } else {
      bf16_t* U = (bf16_t*)(p.ws + OFF_U);
#pragma unroll
      for (int mi = 0; mi < 2; ++mi)
#pragma unroll
        for (int ni = 0; ni < 2; ++ni)
#pragma unroll
          for (int r = 0; r < 16; ++r) {
            int row = mrow0 + mi * 32 + crow(r, h), col = ncol0 + ni * 32 + c;
            U[(size_t)row * INP + col] = f2bf(acc[mi][ni][r]);
          }
    }
  } else if (EPI == EPI_RES1 || EPI == EPI_RES2) {
    const float* mod = (const float*)(p.ws + OFF_MOD) + (size_t)layer * 9 * 6144;
    const int b9 = mrow0 < NLAT ? (mrow0 >> 12) : 8;
    const int gsel = (EPI == EPI_RES1) ? 2 : 5;
    const bool first = (EPI == EPI_RES1) && layer == 0;
    const float* xo_base = xold_ptr(p, layer, first, mrow0) + (ncol0 + c);
    float* xn_base = xnew_ptr(p, mrow0) + (ncol0 + c);
    float gate[2];
#pragma unroll
    for (int ni = 0; ni < 2; ++ni) gate[ni] = mod[b9 * 6144 + gsel * 1024 + ncol0 + ni * 32 + c];
    float xa[16], xb[16];
#define RES_LD(X, mi_, ni_) { _Pragma("unroll") for (int r = 0; r < 16; ++r) X[r] = xo_base[(size_t)((mi_) * 32 + crow(r, h)) * D + (ni_) * 32]; }
#define RES_ST(X, mi_, ni_) { _Pragma("unroll") for (int r = 0; r < 16; ++r) xn_base[(size_t)((mi_) * 32 + crow(r, h)) * D + (ni_) * 32] = X[r] + gate[ni_] * acc[mi_][ni_][r]; }
    RES_LD(xa, 0, 0)
    RES_LD(xb, 0, 1)
    RES_ST(xa, 0, 0)
    RES_LD(xa, 1, 0)
    RES_ST(xb, 0, 1)
    RES_LD(xb, 1, 1)
    RES_ST(xa, 1, 0)
    RES_ST(xb, 1, 1)
#undef RES_LD
#undef RES_ST
  } else if (EPI == EPI_SWIGLU) {
    bf16_t* G = (bf16_t*)(p.ws + OFF_U);
    const int j = (ncol0 >> 7) * 64 + ((ncol0 >> 6) & 1) * 32 + c;
#pragma unroll
    for (int mi = 0; mi < 2; ++mi)
#pragma unroll
      for (int r = 0; r < 16; ++r) {
        int row = mrow0 + mi * 32 + crow(r, h);
        float a1 = acc[mi][0][r], a3 = acc[mi][1][r];
        G[(size_t)row * FFH + j] = f2bf(silu_f(a1) * a3);
      }
  } else if (EPI == EPI_QUP) {
    bf16_t* Qm = (bf16_t*)(p.ws + OFF_QM);
    const float2* csm = (const float2*)(p.ws + OFF_ROPEM);
    const float qs = 0.10206207261596577f * LOG2E;
    const bool lat = mrow0 < NLAT;
    float2 cst[2][16];
#pragma unroll
    for (int mi = 0; mi < 2; ++mi)
#pragma unroll
      for (int r = 0; r < 16; ++r) {
        const int sq = (mrow0 + mi * 32 + crow(r, h)) & 4095;
        const int pos = (c >> 4) ? (sq & 63) : (sq >> 6);
        cst[mi][r] = lat ? csm[pos * 8 + (c & 7)] : make_float2(1.f, 0.f);
      }
#pragma unroll
    for (int ni = 0; ni < 2; ++ni) {
      int cg0 = ncol0 + ni * 32;
      if (cg0 >= 576) continue;
      int head = cg0 / 96, part = (cg0 % 96) >> 5;
#pragma unroll
      for (int mi = 0; mi < 2; ++mi)
#pragma unroll
        for (int r = 0; r < 16; ++r) {
          int row = mrow0 + mi * 32 + crow(r, h);
          int b, kp; row_info(row, b, kp);
          float v = acc[mi][ni][r];
          if (part == 2) {
            float pv = __shfl_xor(v, 8);
            if (lat) {
              const float2 cs = cst[mi][r];
              v = v * cs.x + ((c & 8) ? pv : -pv) * cs.y;
            }
          }
          Qm[((size_t)(b * 6 + head) * NKEY + kp) * 96 + part * 32 + c] = f2bf(v * qs);
        }
    }
  } else if (EPI == EPI_KVUP) {
    bf16_t* Km = (bf16_t*)(p.ws + OFF_KM);
    bf16_t* Vmt = (bf16_t*)(p.ws + OFF_VMT);
#pragma unroll
    for (int ni = 0; ni < 2; ++ni) {
      int cg0 = ncol0 + ni * 32;
      int head = cg0 >> 7, part = (cg0 >> 5) & 3;
#pragma unroll
      for (int mi = 0; mi < 2; ++mi) {
        if (part < 2) {
#pragma unroll
          for (int r = 0; r < 16; ++r) {
            int row = mrow0 + mi * 32 + crow(r, h);
            int b, kp; row_info(row, b, kp);
            Km[((size_t)(b * 6 + head) * NKEY + kp) * 96 + part * 32 + c] = f2bf(acc[mi][ni][r]);
          }
        } else {
#pragma unroll
          for (int g = 0; g < 4; ++g) {
            int row = mrow0 + mi * 32 + 8 * g + 4 * h;
            int b, kp; row_info(row, b, kp);
            uint2 w;
            w.x = pack2(acc[mi][ni][4 * g], acc[mi][ni][4 * g + 1]);
            w.y = pack2(acc[mi][ni][4 * g + 2], acc[mi][ni][4 * g + 3]);
            *(uint2*)(Vmt + ((size_t)(b * 6 + head) * 64 + (part - 2) * 32 + c) * NKEY + kp) = w;
          }
        }
      }
    }
  }
}

template <int EPI>
DI void gemm_phase(const Params& p, int layer, const bf16_t* __restrict__ A, int lda, const bf16_t* __restrict__ Bt, int ldb, int K, int MT, int NT,
                   char* smem, bool rev = false) {
  bf16_t* sA = (bf16_t*)smem;
  bf16_t* sB = sA + 2 * 128 * LDT;
  const int tid = get_tid(), lane = tid & 63, wave = tid >> 6, wr = wave >> 1, wc = wave & 1;
  const int total = MT * NT;
  int t = rev ? (int)(gridDim.x - 1 - blockIdx.x) : (int)blockIdx.x;
  if (t >= total) return;
  uint4 pa0, pa1, pa2, pa3, pb0, pb1, pb2, pb3, qa0, qa1, qa2, qa3, qb0, qb1, qb2, qb3;
  const int lr = tid >> 3, lc = (tid & 7) * 8;
  const int nk = K >> 6;
  const int soff = lr * LDT + lc;
  const int aoff = (wr * 64 + (lane & 31)) * LDT + (lane >> 5) * 8;
  const int boff = (wc * 64 + (lane & 31)) * LDT + (lane >> 5) * 8;
  int mt, nt; tile_map(t, MT, NT, mt, nt);
  int m0 = mt * 128, n0 = nt * 128;
  const bf16_t* Agl = A + (size_t)(m0 + lr) * lda + lc;
  const bf16_t* Bgl = Bt + (size_t)(n0 + lr) * ldb + lc;
#define G_LOAD(P, k0_)                                                   \
  {                                                                      \
    P##a0 = *(const uint4*)(Agl + (k0_));                                \
    P##a1 = *(const uint4*)(Agl + (size_t)32 * lda + (k0_));             \
    P##a2 = *(const uint4*)(Agl + (size_t)64 * lda + (k0_));             \
    P##a3 = *(const uint4*)(Agl + (size_t)96 * lda + (k0_));             \
    P##b0 = *(const uint4*)(Bgl + (k0_));                                \
    P##b1 = *(const uint4*)(Bgl + (size_t)32 * ldb + (k0_));             \
    P##b2 = *(const uint4*)(Bgl + (size_t)64 * ldb + (k0_));             \
    P##b3 = *(const uint4*)(Bgl + (size_t)96 * ldb + (k0_));             \
  }
#define G_WRITE(P, buf_)                                                 \
  {                                                                      \
    bf16_t* wa_ = sA + (buf_) * 128 * LDT + soff;                        \
    bf16_t* wb_ = sB + (buf_) * 128 * LDT + soff;                        \
    *(uint4*)(wa_) = P##a0; *(uint4*)(wa_ + 32 * LDT) = P##a1;           \
    *(uint4*)(wa_ + 64 * LDT) = P##a2; *(uint4*)(wa_ + 96 * LDT) = P##a3;\
    *(uint4*)(wb_) = P##b0; *(uint4*)(wb_ + 32 * LDT) = P##b1;           \
    *(uint4*)(wb_ + 64 * LDT) = P##b2; *(uint4*)(wb_ + 96 * LDT) = P##b3;\
  }
#define G_COMPUTE(buf_)                                                            \
  {                                                                                \
    const bf16_t* a_base = sA + (buf_) * 128 * LDT + aoff;                         \
    const bf16_t* b_base = sB + (buf_) * 128 * LDT + boff;                         \
    __builtin_amdgcn_s_setprio(1);                                                 \
    _Pragma("unroll") for (int ks = 0; ks < 4; ++ks) {                             \
      bf16x8 a0 = *(const bf16x8*)(a_base + ks * 16);                              \
      bf16x8 a1 = *(const bf16x8*)(a_base + 32 * LDT + ks * 16);                   \
      bf16x8 b0 = *(const bf16x8*)(b_base + ks * 16);                              \
      bf16x8 b1 = *(const bf16x8*)(b_base + 32 * LDT + ks * 16);                   \
      acc[0][0] = MFMA32(a0, b0, acc[0][0]);                                       \
      acc[0][1] = MFMA32(a0, b1, acc[0][1]);                                       \
      acc[1][0] = MFMA32(a1, b0, acc[1][0]);                                       \
      acc[1][1] = MFMA32(a1, b1, acc[1][1]);                                       \
    }                                                                              \
    __builtin_amdgcn_s_setprio(0);                                                 \
  }
  G_LOAD(p, 0)
  G_LOAD(q, 64)
  for (;;) {
    G_WRITE(p, 0)
    __syncthreads();
    if (nk > 2) G_LOAD(p, 128)
    f32x16 acc[2][2];
#pragma unroll
    for (int i = 0; i < 2; ++i)
#pragma unroll
      for (int j = 0; j < 2; ++j)
#pragma unroll
        for (int r = 0; r < 16; ++r) acc[i][j][r] = 0.f;
    for (int kt = 0; kt < nk; kt += 2) {
      G_COMPUTE(0)
      G_WRITE(q, 1)
      __syncthreads();
      if (kt + 3 < nk) G_LOAD(q, (kt + 3) << 6)
      G_COMPUTE(1)
      if (kt + 2 < nk) G_WRITE(p, 0)
      __syncthreads();
      if (kt + 4 < nk) G_LOAD(p, (kt + 4) << 6)
    }
    const int tn = t + gridDim.x;
    const bool has_next = tn < total;
    const int m0c = m0, n0c = n0;
    constexpr bool PRE = (EPI != EPI_QUP && EPI != EPI_RES1 && EPI != EPI_RES2);
    if (has_next) {
      tile_map(tn, MT, NT, mt, nt);
      m0 = mt * 128; n0 = nt * 128;
      Agl = A + (size_t)(m0 + lr) * lda + lc;
      Bgl = Bt + (size_t)(n0 + lr) * ldb + lc;
      if (PRE) { G_LOAD(p, 0) G_LOAD(q, 64) }
    }
    epilogue<EPI>(p, layer, acc, m0c + wr * 64, n0c + wc * 64, lane);
    if (!has_next) break;
    if (!PRE) { G_LOAD(p, 0) G_LOAD(q, 64) }
    t = tn;
  }
#undef G_LOAD
#undef G_WRITE
#undef G_COMPUTE
}

struct TrItem { const float* src; bf16_t* dst; int K, N, mode, k0, n0; };
DI TrItem tr_decode(const Params& p, int it) {
  constexpr int T_IN = 16 * 30, T_OUT = 16 * 16, T_W1 = 16 * 44, T_W3 = 16 * 44, T_W2 = 44 * 16, T_UQ = 4 * 10, T_UKV = 2 * 12;
  constexpr int T_LAYER = T_IN + T_OUT + T_W1 + T_W3 + T_W2 + T_UQ + T_UKV;
  const int layer = it / T_LAYER;
  int r = it % T_LAYER;
  bf16_t* wl = (bf16_t*)(p.ws + OFF_W) + (size_t)layer * WL;
  TrItem t;
  int nt;
  if (r < T_IN) { t.src = p.w_in + (size_t)layer * D * INW; t.K = D; t.N = INW; t.dst = wl + W_IN; t.mode = 0; nt = 30; }
  else if ((r -= T_IN) < T_OUT) { t.src = p.w_out + (size_t)layer * D * D; t.K = D; t.N = D; t.dst = wl + W_OUT; t.mode = 0; nt = 16; }
  else if ((r -= T_OUT) < T_W1) { t.src = p.ffn_w1 + (size_t)layer * D * FFH; t.K = D; t.N = FFH; t.dst = wl + W_13; t.mode = 1; nt = 44; }
  else if ((r -= T_W1) < T_W3) { t.src = p.ffn_w3 + (size_t)layer * D * FFH; t.K = D; t.N = FFH; t.dst = wl + W_13; t.mode = 2; nt = 44; }
  else if ((r -= T_W3) < T_W2) { t.src = p.ffn_w2 + (size_t)layer * FFH * D; t.K = FFH; t.N = D; t.dst = wl + W_2; t.mode = 0; nt = 16; }
  else if ((r -= T_W2) < T_UQ) { t.src = p.mla_w_uq + (size_t)layer * 256 * 576; t.K = 256; t.N = 576; t.dst = wl + W_UQ; t.mode = 0; nt = 10; }
  else { r -= T_UQ; t.src = p.mla_w_ukv + (size_t)layer * 128 * 768; t.K = 128; t.N = 768; t.dst = wl + W_UKV; t.mode = 0; nt = 12; }
  t.k0 = (r / nt) * 64; t.n0 = (r % nt) * 64;
  return t;
}
DI void transpose_loop(const Params& p, int n_items, char* smem) {
  bf16_t* sT = (bf16_t*)smem;
  const int tid = get_tid();
  int it = blockIdx.x;
  if (it >= n_items) return;
  const int kr0 = tid >> 4, c4 = tid & 15;
  TrItem cur = tr_decode(p, it);
  float4 v0, v1, v2, v3, w0, w1, w2, w3;
#define TR_LOAD(T, V0, V1, V2, V3)                                                                  \
  {                                                                                                 \
    const int n_ = T.n0 + c4 * 4;                                                                   \
    const float* sp_ = T.src + (size_t)(T.k0 + kr0) * T.N + (n_ < T.N ? n_ : 0);                    \
    V0 = *(const float4*)(sp_); V1 = *(const float4*)(sp_ + (size_t)16 * T.N);                     \
    V2 = *(const float4*)(sp_ + (size_t)32 * T.N); V3 = *(const float4*)(sp_ + (size_t)48 * T.N);   \
    if (n_ >= T.N) { V0 = make_float4(0.f, 0.f, 0.f, 0.f); V1 = V0; V2 = V0; V3 = V0; }             \
  }
  TR_LOAD(cur, v0, v1, v2, v3)
  for (;;) {
    const int itn = it + gridDim.x;
    const bool has = itn < n_items;
    TrItem nxt = cur;
    if (has) { nxt = tr_decode(p, itn); TR_LOAD(nxt, w0, w1, w2, w3) }
#define TR_PUT(V, i_)                                                     \
    {                                                                     \
      const int kr_ = kr0 + 16 * (i_);                                    \
      sT[(c4 * 4 + 0) * 66 + kr_] = f2bf(V.x); sT[(c4 * 4 + 1) * 66 + kr_] = f2bf(V.y); \
      sT[(c4 * 4 + 2) * 66 + kr_] = f2bf(V.z); sT[(c4 * 4 + 3) * 66 + kr_] = f2bf(V.w); \
    }
    TR_PUT(v0, 0) TR_PUT(v1, 1) TR_PUT(v2, 2) TR_PUT(v3, 3)
    __syncthreads();
#pragma unroll
    for (int i = 0; i < 2; ++i) {
      int id = tid + 256 * i, n = id >> 3, k8 = id & 7;
      const unsigned* sp = (const unsigned*)(sT + n * 66 + k8 * 8);
      uint4 w; w.x = sp[0]; w.y = sp[1]; w.z = sp[2]; w.w = sp[3];
      int j = cur.n0 + n, drow = j;
      if (cur.mode != 0) drow = 128 * (j >> 6) + 64 * ((j >> 5) & 1) + (j & 31) + (cur.mode == 2 ? 32 : 0);
      *(uint4*)(cur.dst + (size_t)drow * cur.K + cur.k0 + k8 * 8) = w;
    }
    __syncthreads();
    if (!has) break;
    it = itn; cur = nxt; v0 = w0; v1 = w1; v2 = w2; v3 = w3;
  }
#undef TR_LOAD
#undef TR_PUT
}

DI void modpart_item(const Params& p, int layer, int cb, int ks, char* smem) {
  float* sc = (float*)smem;
  const int tid = get_tid();
  for (int i = tid; i < 9 * 128; i += 256) {
    int b = i >> 7, k = ks * 128 + (i & 127);
    float v = b < 8 ? p.c[b * D + k] : p.c_ctx[k];
    sc[i] = silu_f(v);
  }
  __syncthreads();
  const int n = cb * 256 + tid;
  const float* w = p.mod_w + (size_t)layer * D * 6144 + (size_t)(ks * 128) * 6144 + n;
  float a0 = 0, a1 = 0, a2 = 0, a3 = 0, a4 = 0, a5 = 0, a6 = 0, a7 = 0, a8 = 0;
#pragma unroll 4
  for (int k = 0; k < 128; ++k) {
    float wv = w[(size_t)k * 6144];
    a0 += sc[k] * wv; a1 += sc[128 + k] * wv; a2 += sc[256 + k] * wv; a3 += sc[384 + k] * wv; a4 += sc[512 + k] * wv;
    a5 += sc[640 + k] * wv; a6 += sc[768 + k] * wv; a7 += sc[896 + k] * wv; a8 += sc[1024 + k] * wv;
  }
  float* dst = (float*)(p.ws + OFF_MODP) + ((size_t)(layer * 8 + ks) * 9) * 6144 + n;
  dst[0 * 6144] = a0; dst[1 * 6144] = a1; dst[2 * 6144] = a2; dst[3 * 6144] = a3; dst[4 * 6144] = a4;
  dst[5 * 6144] = a5; dst[6 * 6144] = a6; dst[7 * 6144] = a7; dst[8 * 6144] = a8;
  __syncthreads();
}

DI void filter_item(const Params& p, int layer, int L, int tile, char* smem) {
  float* z = (float*)smem;
  float* h1 = z + 16 * 33;
  float* h2 = h1 + 16 * 64;
  const int tid = get_tid(), m0 = tile * 16;
  const float* w1 = p.hy_filt_w1 + (size_t)layer * 33 * 64;
  const float* b1 = p.hy_filt_b1 + layer * 64;
  const float* w2 = p.hy_filt_w2 + (size_t)layer * 64 * 64;
  const float* b2 = p.hy_filt_b2 + layer * 64;
  const float* w3 = p.hy_filt_w3 + (size_t)layer * 64 * 1024;
  const float* fq = p.hy_filt_freq + layer * 64;
  for (int i = tid; i < 16 * 33; i += 256) {
    int ml = i / 33, e = i % 33, m = m0 + ml;
    float val;
    if (e == 0) val = (float)m / (float)(L - 1);
    else {
      int bi = (e - 1) & 15;
      float f = 1e-4f + (float)bi * ((15.0f - 1e-4f) / 15.0f);
      float wpos = (6.283185307179586f * (float)m) / (float)L;
      float s, c; sincos_acc(f * wpos, s, c);
      val = (e <= 16) ? c : -s;
    }
    z[i] = val;
  }
  __syncthreads();
  for (int i = tid; i < 16 * 64; i += 256) {
    int ml = i >> 6, j = i & 63;
    float a = b1[j];
    for (int e = 0; e < 33; ++e) a += z[ml * 33 + e] * w1[e * 64 + j];
    h1[i] = sin_acc(fq[j] * a);
  }
  __syncthreads();
  for (int i = tid; i < 16 * 64; i += 256) {
    int ml = i >> 6, j = i & 63;
    float a = b2[j];
    for (int e = 0; e < 64; ++e) a += h1[ml * 64 + e] * w2[e * 64 + j];
    h2[i] = sin_acc(fq[j] * a);
  }
  __syncthreads();
  const int ch = tid;
  const float da = -15.350567286626972f, db = -3.0701134573253944f;
  const float delta = fabsf(da + (float)ch * ((db - da) / 255.0f));
  float ps0 = 0.f, ps1 = 0.f;
  float fa[16][4];
#pragma unroll
  for (int ml = 0; ml < 16; ++ml) { fa[ml][0] = 0.f; fa[ml][1] = 0.f; fa[ml][2] = 0.f; fa[ml][3] = 0.f; }
  for (int e = 0; e < 64; ++e) {
    const float* wr = w3 + e * 1024 + ch;
    const float w0 = wr[0], w1v = wr[256], w2v = wr[512], w3v = wr[768];
#pragma unroll
    for (int ml = 0; ml < 16; ++ml) {
      const float hv = h2[ml * 64 + e];
      fa[ml][0] += hv * w0; fa[ml][1] += hv * w1v; fa[ml][2] += hv * w2v; fa[ml][3] += hv * w3v;
    }
  }
#pragma unroll
  for (int ml = 0; ml < 16; ++ml) {
    float a00 = fa[ml][0], a01 = fa[ml][1], a10 = fa[ml][2], a11 = fa[ml][3];
    const int m = m0 + ml;
    const float t = (float)m / (float)(L - 1);
    const float dec = __expf(-t * delta);
    a00 *= dec; a01 *= dec; a10 *= dec; a11 *= dec;
    ps0 += fabsf(a00); ps1 += fabsf(a10);
    if (m > 0) { ps0 += fabsf(a01); ps1 += fabsf(a11); }
    if (L == SEQ) {
      bf16_t* k0 = (bf16_t*)(p.ws + OFF_KREV) + ((size_t)(layer * 2 + 0) * 256 + ch) * 8192;
      bf16_t* k1 = (bf16_t*)(p.ws + OFF_KREV) + ((size_t)(layer * 2 + 1) * 256 + ch) * 8192;
      k0[L - 1 - m] = f2bf(a00); k1[L - 1 - m] = f2bf(a10);
      if (m > 0) { k0[L - 1 + m] = f2bf(a01); k1[L - 1 + m] = f2bf(a11); }
      else { k0[2 * L - 1] = 0; k1[2 * L - 1] = 0; }
    } else {
      float* k0 = (float*)(p.ws + OFF_KREVC) + ((size_t)0 * 256 + ch) * 512;
      float* k1 = (float*)(p.ws + OFF_KREVC) + ((size_t)1 * 256 + ch) * 512;
      k0[L - 1 - m] = a00; k1[L - 1 - m] = a10;
      if (m > 0) { k0[L - 1 + m] = a01; k1[L - 1 + m] = a11; }
      else { k0[2 * L - 1] = 0.f; k1[2 * L - 1] = 0.f; }
    }
  }
  float* pn = (L == SEQ) ? (float*)(p.ws + OFF_PN) + ((size_t)layer * 256 + tile) * 512 : (float*)(p.ws + OFF_PNC) + (size_t)tile * 512;
  pn[ch] = ps0; pn[256 + ch] = ps1;
  __syncthreads();
}

DI void phase_prologue(const Params& p, char* smem) {
  constexpr int T_IN = 16 * 30, T_OUT = 16 * 16, T_W1 = 16 * 44, T_W3 = 16 * 44, T_W2 = 44 * 16, T_UQ = 4 * 10, T_UKV = 2 * 12;
  constexpr int T_LAYER = T_IN + T_OUT + T_W1 + T_W3 + T_W2 + T_UQ + T_UKV;
  constexpr int N_TR = 2 * T_LAYER, N_MOD = 2 * 24 * 8, N_FILT = 2 * 256 + 16;
  constexpr int N_ALL = N_TR + N_MOD + N_FILT + 1;
  transpose_loop(p, N_TR, smem);
  for (int it = N_TR + blockIdx.x; it < N_ALL; it += gridDim.x) {
    if (false) {
    } else if (it < N_TR + N_MOD) {
      int r = it - N_TR;
      int layer = r / 192, q = r % 192;
      modpart_item(p, layer, q >> 3, q & 7, smem);
    } else if (it < N_TR + N_MOD + N_FILT) {
      int r = it - N_TR - N_MOD;
      if (r < 512) filter_item(p, r >> 8, SEQ, r & 255, smem);
      else filter_item(p, 0, CTX, r - 512, smem);
    } else {
      float2* cg_ = (float2*)(p.ws + OFF_ROPEG);
      float2* cm_ = (float2*)(p.ws + OFF_ROPEM);
      for (int i = get_tid(); i < 64 * 16; i += 256) {
        int pos = i >> 4, f = i & 15;
        float inv = exp2f(-((float)(2 * f) / 32.0f) * 13.287712379549449f);
        float s, c; sincos_acc((float)pos * inv, s, c);
        cg_[i] = make_float2(c, s);
      }
      for (int i = get_tid(); i < 64 * 8; i += 256) {
        int pos = i >> 3, f = i & 7;
        float inv = exp2f(-((float)(2 * f) / 16.0f) * 13.287712379549449f);
        float s, c; sincos_acc((float)pos * inv, s, c);
        cm_[i] = make_float2(c, s);
      }
    }
  }
}

DI void phase_modfinal(const Params& p) {
  const int total = 2 * 9 * 6144;
  float* mod = (float*)(p.ws + OFF_MOD);
  const float* mp = (const float*)(p.ws + OFF_MODP);
  for (int i = blockIdx.x * 256 + get_tid(); i < total; i += gridDim.x * 256) {
    int layer = i / (9 * 6144), r = i % (9 * 6144), n = r % 6144;
    float a = p.mod_b[layer * 6144 + n];
#pragma unroll
    for (int ks = 0; ks < 8; ++ks) a += mp[((size_t)(layer * 8 + ks) * 9) * 6144 + r];
    mod[i] = a;
  }
}

DI void phase_norm(const Params& p, int layer, int which  , int nrows) {
  const int lane = get_tid() & 63, gw = blockIdx.x * 4 + (get_tid() >> 6), nw = gridDim.x * 4;
  const float* g = (which == 0 ? p.norm1_g : p.norm2_g) + layer * D;
  const float* mod = (const float*)(p.ws + OFF_MOD) + (size_t)layer * 9 * 6144;
  bf16_t* H = (bf16_t*)(p.ws + OFF_H);
  const bool first = (which == 0) && layer == 0;
  for (int pr = gw; pr < (nrows >> 1); pr += nw) {
    const int row = pr * 2;
    const float* xr0 = xold_ptr(p, layer, first, row);
    const float* xr1 = xold_ptr(p, layer, first, row + 1);
    const int b9 = row < NLAT ? (row >> 12) : 8;
    float4 v[2][4];
    float ss0 = 0.f, ss1 = 0.f;
#pragma unroll
    for (int i = 0; i < 4; ++i) { v[0][i] = ((const float4*)xr0)[lane + 64 * i]; v[1][i] = ((const float4*)xr1)[lane + 64 * i]; }
    const float* sh = mod + b9 * 6144 + (which == 0 ? 0 : 3) * 1024;
    const float* sc = sh + 1024;
    float4 gg[4], s4[4], h4[4];
#pragma unroll
    for (int i = 0; i < 4; ++i) {
      const int col = 4 * (lane + 64 * i);
      gg[i] = *(const float4*)(g + col); s4[i] = *(const float4*)(sc + col); h4[i] = *(const float4*)(sh + col);
    }
#pragma unroll
    for (int i = 0; i < 4; ++i) {
      ss0 += v[0][i].x * v[0][i].x + v[0][i].y * v[0][i].y + v[0][i].z * v[0][i].z + v[0][i].w * v[0][i].w;
      ss1 += v[1][i].x * v[1][i].x + v[1][i].y * v[1][i].y + v[1][i].z * v[1][i].z + v[1][i].w * v[1][i].w;
    }
    ss0 = wave_sum(ss0); ss1 = wave_sum(ss1);
    const float rstd0 = rsqrtf(ss0 * (1.0f / D) + 1e-6f), rstd1 = rsqrtf(ss1 * (1.0f / D) + 1e-6f);
#pragma unroll
    for (int k = 0; k < 2; ++k) {
      const float rstd = k == 0 ? rstd0 : rstd1;
#pragma unroll
      for (int i = 0; i < 4; ++i) {
        const int col = 4 * (lane + 64 * i);
        float y0 = v[k][i].x * rstd * gg[i].x * (1.f + s4[i].x) + h4[i].x;
        float y1 = v[k][i].y * rstd * gg[i].y * (1.f + s4[i].y) + h4[i].y;
        float y2 = v[k][i].z * rstd * gg[i].z * (1.f + s4[i].z) + h4[i].z;
        float y3 = v[k][i].w * rstd * gg[i].w * (1.f + s4[i].w) + h4[i].w;
        uint2 w; w.x = pack2(y0, y1); w.y = pack2(y2, y3);
        *(uint2*)(H + (size_t)(row + k) * D + col) = w;
      }
    }
  }
}

DI void phase_final(const Params& p) {
  const int lane = get_tid() & 63, gw = blockIdx.x * 4 + (get_tid() >> 6), nw = gridDim.x * 4;
  for (int pr = gw; pr < (NLAT >> 1); pr += nw) {
    float* xr0 = p.out + (size_t)(2 * pr) * D;
    float* xr1 = xr0 + D;
    float4 v[2][4], gg[4];
    float ss0 = 0.f, ss1 = 0.f;
#pragma unroll
    for (int i = 0; i < 4; ++i) { v[0][i] = ((const float4*)xr0)[lane + 64 * i]; v[1][i] = ((const float4*)xr1)[lane + 64 * i]; }
#pragma unroll
    for (int i = 0; i < 4; ++i) gg[i] = *(const float4*)(p.final_g + 4 * (lane + 64 * i));
#pragma unroll
    for (int i = 0; i < 4; ++i) {
      ss0 += v[0][i].x * v[0][i].x + v[0][i].y * v[0][i].y + v[0][i].z * v[0][i].z + v[0][i].w * v[0][i].w;
      ss1 += v[1][i].x * v[1][i].x + v[1][i].y * v[1][i].y + v[1][i].z * v[1][i].z + v[1][i].w * v[1][i].w;
    }
    ss0 = wave_sum(ss0); ss1 = wave_sum(ss1);
    const float r0 = rsqrtf(ss0 * (1.0f / D) + 1e-6f), r1 = rsqrtf(ss1 * (1.0f / D) + 1e-6f);
#pragma unroll
    for (int i = 0; i < 4; ++i) {
      ((float4*)xr0)[lane + 64 * i] = make_float4(v[0][i].x * r0 * gg[i].x, v[0][i].y * r0 * gg[i].y, v[0][i].z * r0 * gg[i].z, v[0][i].w * r0 * gg[i].w);
      ((float4*)xr1)[lane + 64 * i] = make_float4(v[1][i].x * r1 * gg[i].x, v[1][i].y * r1 * gg[i].y, v[1][i].z * r1 * gg[i].z, v[1][i].w * r1 * gg[i].w);
    }
  }
}

struct PrepRow { bf16_t hv[8]; bf16_t kr; uint2 mq; unsigned mkv; float2 cs, tm; };
DI void prep_row_load(const Params& p, int row, const bf16_t* ur, int lane, PrepRow& R) {
  {
    const float2* csg = (const float2*)(p.ws + OFF_ROPEG);
    const float2* csm = (const float2*)(p.ws + OFF_ROPEM);
    const int s = row & 4095, d = lane & 31;
    const int pg = (lane >> 5) ? (s & 63) : (s >> 6), pm = (d >> 4) ? (s & 63) : (s >> 6);
    R.cs = csg[pg * 16 + (lane & 15)];
    R.tm = csm[pm * 8 + (d & 7)];
    if (row >= NLAT) { R.cs = make_float2(1.f, 0.f); R.tm = make_float2(1.f, 0.f); }
  }
#pragma unroll
  for (int hd = 0; hd < 8; ++hd) R.hv[hd] = ur[768 + hd * 64 + lane];
  R.mq = *(const uint2*)(ur + 1408 + lane * 4);
  R.mkv = *(const unsigned*)(ur + 1664 + lane * 2);
  R.kr = ur[1792 + (lane & 31)];
}
DI void prep_row_store(const Params& p, int layer, int row, int lane, const PrepRow& R, float gq, float gk, float4 g4, float2 g2) {
  bf16_t* Qg = (bf16_t*)(p.ws + OFF_QG);
  bf16_t* Kg = (bf16_t*)(p.ws + OFF_KG);
  bf16_t* Km = (bf16_t*)(p.ws + OFF_KM);
  bf16_t* MQN = (bf16_t*)(p.ws + OFF_MQN);
  bf16_t* MKVN = (bf16_t*)(p.ws + OFF_MKVN);
  const float qs = 0.125f * LOG2E;
  int b, kp; row_info(row, b, kp);
  const bool lat = row < NLAT;
  const int s = row & 4095;
  const float cs_c = R.cs.x, cs_s = R.cs.y;
  const float2 tm = R.tm;
  (void)s;
  const bool upper = (lane >> 4) & 1;
#pragma unroll
  for (int hd = 0; hd < 8; ++hd) {
    float xv = bf2f(R.hv[hd]);
    float ss = wave_sum(xv * xv);
    float y = xv * rsqrtf(ss * (1.0f / 64.f) + 1e-6f) * (hd < 6 ? gq : gk);
    float pv = __shfl_xor(y, 16);
    float o = y * cs_c + (upper ? pv : -pv) * cs_s;
    if (hd < 6) Qg[((size_t)(b * 6 + hd) * NKEY + kp) * 64 + lane] = f2bf(o * qs);
    else Kg[((size_t)(b * 2 + (hd - 6)) * NKEY + kp) * 64 + lane] = f2bf(o);
  }
  {
    const uint2 w = R.mq;
    float x0 = bf2f((bf16_t)(w.x & 0xffff)), x1 = bf2f((bf16_t)(w.x >> 16)), x2 = bf2f((bf16_t)(w.y & 0xffff)), x3 = bf2f((bf16_t)(w.y >> 16));
    float ss = wave_sum(x0 * x0 + x1 * x1 + x2 * x2 + x3 * x3);
    float rstd = rsqrtf(ss * (1.0f / 256.f) + 1e-6f);
    uint2 o; o.x = pack2(x0 * rstd * g4.x, x1 * rstd * g4.y); o.y = pack2(x2 * rstd * g4.z, x3 * rstd * g4.w);
    *(uint2*)(MQN + (size_t)row * 256 + lane * 4) = o;
  }
  {
    const unsigned w = R.mkv;
    float x0 = bf2f((bf16_t)(w & 0xffff)), x1 = bf2f((bf16_t)(w >> 16));
    float ss = wave_sum(x0 * x0 + x1 * x1);
    float rstd = rsqrtf(ss * (1.0f / 128.f) + 1e-6f);
    *(unsigned*)(MKVN + (size_t)row * 128 + lane * 2) = pack2(x0 * rstd * g2.x, x1 * rstd * g2.y);
  }
  {
    int d = lane & 31;
    float xv = bf2f(R.kr);
    float pv = __shfl_xor(xv, 8);
    float o = lat ? (xv * tm.x + ((d & 8) ? pv : -pv) * tm.y) : xv;
    bf16_t ob = f2bf(o);
    int hb = (lane >> 5) * 3;
#pragma unroll
    for (int hh = 0; hh < 3; ++hh) Km[((size_t)(b * 6 + hb + hh) * NKEY + kp) * 96 + 64 + d] = ob;
  }
}
DI void prep_rows(const Params& p, int layer) {
  const int lane = get_tid() & 63, gw = blockIdx.x * 4 + (get_tid() >> 6), nw = gridDim.x * 4;
  const bf16_t* U = (const bf16_t*)(p.ws + OFF_U);
  const float gq = p.gqa_q_g[layer * 64 + lane], gk = p.gqa_k_g[layer * 64 + lane];
  const float4 g4 = *(const float4*)(p.mla_q_g + layer * 256 + lane * 4);
  const float2 g2 = *(const float2*)(p.mla_kv_g + layer * 128 + lane * 2);
  for (int pr = gw; pr < (NTOK >> 1); pr += nw) {
    const int row = pr * 2;
    PrepRow Ra, Rb;
    prep_row_load(p, row, U + (size_t)row * INP, lane, Ra);
    prep_row_load(p, row + 1, U + (size_t)(row + 1) * INP, lane, Rb);
    prep_row_store(p, layer, row, lane, Ra, gq, gk, g4, g2);
    prep_row_store(p, layer, row + 1, lane, Rb, gq, gk, g4, g2);
  }
}

DI void prep_hy_loop(const Params& p, int layer, int n_items, char* smem) {
  bf16_t* sT = (bf16_t*)smem;
  const int tid = get_tid();
  const bf16_t* U = (const bf16_t*)(p.ws + OFF_U);
  bf16_t* HT = (bf16_t*)(p.ws + OFF_HT);
  const int c8 = tid & 7, tk0 = tid >> 3;
  int it = blockIdx.x;
  if (it >= n_items) return;
  uint4 cur[4], prv[4], nxt[4], ncur[4], nprv[4], nnxt[4];
  float w0[8], w1[8], w2[8], wb[8], nw0[8], nw1[8], nw2[8], nwb[8];
#define HY_LOAD(it_, CUR, PRV, NXT, W0, W1, W2, WB)                                           \
  {                                                                                           \
    const int tile_ = (it_) / 12, cgp_ = (it_) % 12;                                          \
    const int row0_ = tile_ * 128, s0_ = row0_ & 4095, ch0_ = cgp_ * 64 + c8 * 8;             \
    const float* cw_ = p.hy_conv_w + (size_t)layer * 3 * 768 + ch0_;                          \
    const float* cb_ = p.hy_conv_b + layer * 768 + ch0_;                                      \
    _Pragma("unroll") for (int i = 0; i < 4; ++i) {                                           \
      const int tk = tk0 + 32 * i, sq = s0_ + tk;                                             \
      const bf16_t* ur = U + (size_t)(row0_ + tk) * INP + ch0_;                               \
      CUR[i] = *(const uint4*)ur;                                                             \
      PRV[i] = *(const uint4*)(ur - (sq > 0 ? INP : 0));                                      \
      NXT[i] = *(const uint4*)(ur + (sq < SEQ - 1 ? INP : 0));                                \
    }                                                                                         \
    _Pragma("unroll") for (int e = 0; e < 8; ++e) { W0[e] = cw_[e]; W1[e] = cw_[768 + e]; W2[e] = cw_[1536 + e]; WB[e] = cb_[e]; } \
  }
  HY_LOAD(it, cur, prv, nxt, w0, w1, w2, wb)
  for (;;) {
    const int itn = it + gridDim.x;
    const bool has = itn < n_items;
    if (has) HY_LOAD(itn, ncur, nprv, nnxt, nw0, nw1, nw2, nwb)
    const int tile = it / 12, cgp = it % 12;
    const int row0 = tile * 128, b = row0 >> 12, s0 = row0 & 4095;
#pragma unroll
    for (int i = 0; i < 4; ++i) {
      const int tk = tk0 + 32 * i, sq = s0 + tk;
      const unsigned mp_ = sq > 0 ? 0xffffffffu : 0u, mn_ = sq < SEQ - 1 ? 0xffffffffu : 0u;
      const unsigned pc[4] = {cur[i].x, cur[i].y, cur[i].z, cur[i].w}, pp[4] = {prv[i].x & mp_, prv[i].y & mp_, prv[i].z & mp_, prv[i].w & mp_},
                     pn[4] = {nxt[i].x & mn_, nxt[i].y & mn_, nxt[i].z & mn_, nxt[i].w & mn_};
#pragma unroll
      for (int e = 0; e < 8; ++e) {
        float xc = bf2f((bf16_t)((pc[e >> 1] >> ((e & 1) * 16)) & 0xffff));
        float xp = bf2f((bf16_t)((pp[e >> 1] >> ((e & 1) * 16)) & 0xffff));
        float xn = bf2f((bf16_t)((pn[e >> 1] >> ((e & 1) * 16)) & 0xffff));
        float o = xp * w0[e] + xc * w1[e] + xn * w2[e] + wb[e];
        sT[(c8 * 8 + e) * 130 + tk] = f2bf(o);
      }
    }
    __syncthreads();
    const int which = cgp >> 2, cbase = (cgp & 3) * 64;
#pragma unroll
    for (int i = 0; i < 4; ++i) {
      int id = tid + 256 * i, ch = id >> 4, t8 = id & 15;
      const unsigned* sp = (const unsigned*)(sT + ch * 130 + t8 * 8);
      uint4 w; w.x = sp[0]; w.y = sp[1]; w.z = sp[2]; w.w = sp[3];
      *(uint4*)(HT + (((size_t)which * NB + b) * 256 + cbase + ch) * SEQ + s0 + t8 * 8) = w;
    }
    __syncthreads();
    if (!has) break;
    it = itn;
#pragma unroll
    for (int i = 0; i < 4; ++i) { cur[i] = ncur[i]; prv[i] = nprv[i]; nxt[i] = nnxt[i]; }
#pragma unroll
    for (int e = 0; e < 8; ++e) { w0[e] = nw0[e]; w1[e] = nw1[e]; w2[e] = nw2[e]; wb[e] = nwb[e]; }
  }
#undef HY_LOAD
}

DI void phase_prep(const Params& p, int layer, char* smem) {
  (void)smem;
  prep_rows(p, layer);
}

constexpr int ZB = 40;
constexpr int ZROW = 192 * ZB;
DI bf16x8 toeplitz_frag(const u32x4& lo, const u32x4& hi, bool b0, bool b1, unsigned sh) {
  const unsigned d0 = lo[0], d1 = lo[1], d2 = lo[2], d3 = lo[3], d4 = hi[0], d5 = hi[1], d6 = hi[2], d7 = hi[3];
  const unsigned t0 = b0 ? d1 : d0, t1 = b0 ? d2 : d1, t2 = b0 ? d3 : d2, t3 = b0 ? d4 : d3, t4 = b0 ? d5 : d4, t5 = b0 ? d6 : d5, t6 = b0 ? d7 : d6;
  const unsigned e0 = b1 ? t2 : t0, e1 = b1 ? t3 : t1, e2 = b1 ? t4 : t2, e3 = b1 ? t5 : t3, e4 = b1 ? t6 : t4;
  u32x4 o = {__builtin_amdgcn_alignbit(e1, e0, sh), __builtin_amdgcn_alignbit(e2, e1, sh), __builtin_amdgcn_alignbit(e3, e2, sh),
             __builtin_amdgcn_alignbit(e4, e3, sh)};
  return __builtin_bit_cast(bf16x8, o);
}
#define HY_BODY(d_)                                                                        \
  {                                                                                        \
    const bf16_t* ap_ = sK + ((SEQ - 1) - 32 * (d_) - r + 8 * h - phi);    \
    const u32x4 w0_ = *(const u32x4*)ap_, w1_ = *(const u32x4*)(ap_ + 8);                  \
    const u32x4 w2_ = *(const u32x4*)(ap_ + 16), w3_ = *(const u32x4*)(ap_ + 24);          \
    const bf16x8 af0_ = toeplitz_frag(w0_, w1_, pb0, pb1, psh);                            \
    const bf16x8 af1_ = toeplitz_frag(w2_, w3_, pb0, pb1, psh);                            \
    const bf16_t* zb_ = sZ + (32 * q + r - (d_) + 32) * ZB + 8 * h;                        \
    _Pragma("unroll") for (int bb_ = 0; bb_ < 4; ++bb_) {                                  \
      const bf16x8 b0_ = *(const bf16x8*)(zb_ + bb_ * ZROW);                               \
      const bf16x8 b1_ = *(const bf16x8*)(zb_ + bb_ * ZROW + 16);                          \
      acc[bb_] = MFMA32(af0_, b0_, acc[bb_]);                                              \
      acc[bb_] = MFMA32(af1_, b1_, acc[bb_]);                                              \
    }                                                                                      \
  }
DI void hyena_conv(const bf16_t* sK, const bf16_t* sZ, f32x16 (&acc)[4], int q, int lane) {
  const int r = lane & 31, h = lane >> 5;
  const int phi = (7 - r) & 7;
  const bool pb0 = (phi >> 1) & 1, pb1 = (phi >> 2) & 1;
  const unsigned psh = (phi & 1) * 16;
#pragma unroll
  for (int bb = 0; bb < 4; ++bb)
#pragma unroll
    for (int i = 0; i < 16; ++i) acc[bb][i] = 0.f;
  int dlo = 32 * q - 127, dhi = 32 * q + 31;
  asm volatile("" : "+s"(dlo), "+s"(dhi));
  for (int d = dlo; d < dhi; d += 2) {
    HY_BODY(d)
    HY_BODY(d + 1)
  }
  HY_BODY(dhi)
}
#undef HY_BODY

struct HyRaw4 { uint2 v; bf16_t m, pz; };
DI HyRaw4 hy_raw4(const bf16_t* u, int t0) {
  HyRaw4 r;
  r.v = *(const uint2*)(u + t0);
  r.m = u[t0 > 0 ? t0 - 1 : 0];
  r.pz = u[t0 + 4 < SEQ ? t0 + 4 : SEQ - 1];
  return r;
}
DI float rbf(float x) { return bf2f(f2bf(x)); }
DI void hy_conv4(const HyRaw4& r, int t0, float w0, float w1, float w2, float wb, float (&o)[4]) {
  const float xm = t0 > 0 ? bf2f(r.m) : 0.f, xp = t0 + 4 < SEQ ? bf2f(r.pz) : 0.f;
  const float e0 = bf2f((bf16_t)(r.v.x & 0xffff)), e1 = bf2f((bf16_t)(r.v.x >> 16)), e2 = bf2f((bf16_t)(r.v.y & 0xffff)), e3 = bf2f((bf16_t)(r.v.y >> 16));
  o[0] = rbf(xm * w0 + e0 * w1 + e1 * w2 + wb);
  o[1] = rbf(e0 * w0 + e1 * w1 + e2 * w2 + wb);
  o[2] = rbf(e1 * w0 + e2 * w1 + e3 * w2 + wb);
  o[3] = rbf(e2 * w0 + e3 * w1 + xp * w2 + wb);
}

DI void hyena_item(const Params& p, int layer, int c, int bh, char* smem) {
  bf16_t* sZ = (bf16_t*)smem;
  bf16_t* sK = sZ + 4 * ZROW;
  float* red = (float*)(sK + 8192);
  const int tid = get_tid(), lane = tid & 63, wave = tid >> 6;
  const bf16_t* HT = (const bf16_t*)(p.ws + OFF_HT);
  const float* cw_ = p.hy_conv_w + (size_t)layer * 3 * 768 + c;
  const float* cb_ = p.hy_conv_b + layer * 768 + c;
  const float vw0 = cw_[0], vw1 = cw_[768], vw2 = cw_[1536], vwb = cb_[0];
  const float aw0 = cw_[256], aw1 = cw_[768 + 256], aw2 = cw_[1536 + 256], awb = cb_[256];
  const float gw0 = cw_[512], gw1 = cw_[768 + 512], gw2 = cw_[1536 + 512], gwb = cb_[512];
  {
    const float* pn = (const float*)(p.ws + OFF_PN) + (size_t)layer * 256 * 512;
    float v0 = pn[(size_t)tid * 512 + c], v1 = pn[(size_t)tid * 512 + 256 + c];
    v0 = wave_sum(v0); v1 = wave_sum(v1);
    if (lane == 0) { red[wave] = v0; red[4 + wave] = v1; }
  }
  {
    bf16_t* zw = sZ + wave * ZROW;
    for (int i = lane; i < 32 * ZB / 8; i += 64) {
      *(uint4*)(zw + i * 8) = make_uint4(0, 0, 0, 0);
      *(uint4*)(zw + 160 * ZB + i * 8) = make_uint4(0, 0, 0, 0);
    }
    const bf16_t* vsrc = HT + (((size_t)0 * NB + bh * 4 + wave) * 256 + c) * SEQ;
    uint4 wv[8]; bf16_t wm[8], wp[8];
#pragma unroll
    for (int jj = 0; jj < 8; ++jj) {
      const int j = lane + 64 * jj;
      wv[jj] = *(const uint4*)(vsrc + j * 8);
      wm[jj] = vsrc[j > 0 ? j * 8 - 1 : 0];
      wp[jj] = vsrc[j < 511 ? j * 8 + 8 : SEQ - 1];
    }
#pragma unroll
    for (int jj = 0; jj < 8; ++jj) {
      const int j = lane + 64 * jj;
      const unsigned pw[4] = {wv[jj].x, wv[jj].y, wv[jj].z, wv[jj].w};
      float e[10];
      e[0] = j > 0 ? bf2f(wm[jj]) : 0.f;
      e[9] = j < 511 ? bf2f(wp[jj]) : 0.f;
#pragma unroll
      for (int k = 0; k < 8; ++k) e[k + 1] = bf2f((bf16_t)((pw[k >> 1] >> ((k & 1) * 16)) & 0xffff));
      float o[8];
#pragma unroll
      for (int k = 0; k < 8; ++k) o[k] = e[k] * vw0 + e[k + 1] * vw1 + e[k + 2] * vw2 + vwb;
      uint4 w; w.x = pack2(o[0], o[1]); w.y = pack2(o[2], o[3]); w.z = pack2(o[4], o[5]); w.w = pack2(o[6], o[7]);
      *(uint4*)(zw + ((j >> 2) + 32) * ZB + (j & 3) * 8) = w;
    }
  }
  const bf16_t* kr = (const bf16_t*)(p.ws + OFF_KREV) + ((size_t)(layer * 2 + 0) * 256 + c) * 8192;
  for (int i = tid; i < 1024; i += 256) *(uint4*)(sK + i * 8) = *(const uint4*)(kr + i * 8);
  __syncthreads();
  const float inv0 = 1.0f / (red[0] + red[1] + red[2] + red[3]);
  const float inv1 = 1.0f / (red[4] + red[5] + red[6] + red[7]);
  const float bias0 = p.hy_bias[(layer * 2 + 0) * 256 + c], bias1 = p.hy_bias[(layer * 2 + 1) * 256 + c];
  f32x16 acc[4];
  const int q = __builtin_amdgcn_readfirstlane(wave), n = lane & 31, h = lane >> 5;
  const int i = 32 * q + n;
  hyena_conv(sK, sZ, acc, q, lane);
  __syncthreads();
  kr = (const bf16_t*)(p.ws + OFF_KREV) + ((size_t)(layer * 2 + 1) * 256 + c) * 8192;
  for (int ii = tid; ii < 1024; ii += 256) *(uint4*)(sK + ii * 8) = *(const uint4*)(kr + ii * 8);
#pragma unroll
  for (int bb = 0; bb < 4; ++bb) {
    const bf16_t* x1 = HT + (((size_t)1 * NB + bh * 4 + bb) * 256 + c) * SEQ;
    bf16_t* zw = sZ + bb * ZROW;
#pragma unroll
    for (int g = 0; g < 4; ++g) {
      const int off = 8 * g + 4 * h;
      float xa[4];
      hy_conv4(hy_raw4(x1, i * 32 + off), i * 32 + off, aw0, aw1, aw2, awb, xa);
      uint2* zp = (uint2*)(zw + (i + 32) * ZB + off);
      uint2 vv = *zp;
      float z0 = xa[0] * (acc[bb][4 * g + 0] * inv0 + bf2f((bf16_t)(vv.x & 0xffff)) * bias0);
      float z1 = xa[1] * (acc[bb][4 * g + 1] * inv0 + bf2f((bf16_t)(vv.x >> 16)) * bias0);
      float z2 = xa[2] * (acc[bb][4 * g + 2] * inv0 + bf2f((bf16_t)(vv.y & 0xffff)) * bias0);
      float z3 = xa[3] * (acc[bb][4 * g + 3] * inv0 + bf2f((bf16_t)(vv.y >> 16)) * bias0);
      uint2 o; o.x = pack2(z0, z1); o.y = pack2(z2, z3);
      *zp = o;
    }
  }
  __syncthreads();
  hyena_conv(sK, sZ, acc, q, lane);
#pragma unroll
  for (int bb = 0; bb < 4; ++bb) {
    const int b = bh * 4 + bb;
    const bf16_t* x2 = HT + (((size_t)2 * NB + b) * 256 + c) * SEQ;
    const bf16_t* zw = sZ + bb * ZROW;
    bf16_t* YT = (bf16_t*)(p.ws + OFF_H + (4u << 20)) + ((size_t)b * 256 + c) * SEQ;
    HyRaw4 xq[4];
#pragma unroll
    for (int g = 0; g < 4; ++g) xq[g] = hy_raw4(x2, i * 32 + 8 * g + 4 * h);
#pragma unroll
    for (int g = 0; g < 4; ++g) {
      const int off = 8 * g + 4 * h;
      float xg[4];
      hy_conv4(xq[g], i * 32 + off, gw0, gw1, gw2, gwb, xg);
      uint2 vv = *(const uint2*)(zw + (i + 32) * ZB + off);
      float y0 = xg[0] * (acc[bb][4 * g + 0] * inv1 + bf2f((bf16_t)(vv.x & 0xffff)) * bias1);
      float y1 = xg[1] * (acc[bb][4 * g + 1] * inv1 + bf2f((bf16_t)(vv.x >> 16)) * bias1);
      float y2 = xg[2] * (acc[bb][4 * g + 2] * inv1 + bf2f((bf16_t)(vv.y & 0xffff)) * bias1);
      float y3 = xg[3] * (acc[bb][4 * g + 3] * inv1 + bf2f((bf16_t)(vv.y >> 16)) * bias1);
      uint2 o; o.x = pack2(y0, y1); o.y = pack2(y2, y3);
      *(uint2*)(YT + i * 32 + off) = o;
    }
  }
  __syncthreads();
}

DI void hyena_ctx_item(const Params& p, int layer, int b, int c, char* smem) {
  float* kf = (float*)smem;
  float* z = kf + 512;
  float* red = z + 256;
  const int tid = get_tid(), lane = tid & 63, wave = tid >> 6;
  const bf16_t* U = (const bf16_t*)(p.ws + OFF_U);
  const float* cw = p.hy_conv_w + (size_t)layer * 3 * 768;
  const float* cb = p.hy_conv_b + layer * 768;
  const int t = tid;
  const size_t rbase = (size_t)(NLAT + b * CTX + t) * INP;
  float hv[3];
#pragma unroll
  for (int w = 0; w < 3; ++w) {
    int ch = w * 256 + c;
    float xc = bf2f(U[rbase + ch]);
    float xp = bf2f(U[rbase - (t > 0 ? INP : 0) + ch]);
    float xn = bf2f(U[rbase + (t < CTX - 1 ? INP : 0) + ch]);
    if (t == 0) xp = 0.f;
    if (t == CTX - 1) xn = 0.f;
    hv[w] = xp * cw[ch] + xc * cw[768 + ch] + xn * cw[1536 + ch] + cb[ch];
  }
  {
    const float* pn = (const float*)(p.ws + OFF_PNC);
    float v0 = tid < 16 ? pn[tid * 512 + c] : 0.f, v1 = tid < 16 ? pn[tid * 512 + 256 + c] : 0.f;
    v0 = wave_sum(v0); v1 = wave_sum(v1);
    if (tid == 0) { red[0] = v0; red[1] = v1; }
  }
  float y = 0.f, zin = hv[0];
#pragma unroll
  for (int o = 0; o < 2; ++o) {
    const float* kr = (const float*)(p.ws + OFF_KREVC) + ((size_t)o * 256 + c) * 512;
    __syncthreads();
    kf[tid] = kr[tid]; kf[256 + tid] = kr[256 + tid];
    z[tid] = zin;
    __syncthreads();
    float a = 0.f;
    for (int s = 0; s < CTX; ++s) a += kf[CTX - 1 - t + s] * z[s];
    const float inv = 1.0f / red[o];
    const float bias = p.hy_bias[(layer * 2 + o) * 256 + c];
    y = hv[1 + o] * (a * inv + zin * bias);
    zin = y;
  }
  bf16_t* YC = (bf16_t*)(p.ws + OFF_H);
  YC[(size_t)(b * CTX + t) * 256 + c] = f2bf(y);
  __syncthreads();
}

template <int DQK>
DI void attn_item(const bf16_t* __restrict__ Q, const bf16_t* __restrict__ Kp, const bf16_t* __restrict__ Vt, int q0, int nkeys,
                  bf16_t* __restrict__ mix, int colbase, int b, char* smem) {
  constexpr int KROW = DQK + 8, NSTEP = DQK / 16, KCH = DQK / 8;
  constexpr bool K3 = (DQK == 96);
  constexpr int VROW = 68;
  bf16_t* sK = (bf16_t*)smem;
  bf16_t* sV = sK + 2 * 64 * KROW;
  const int tid = get_tid(), lane = tid & 63, wave = tid >> 6, r = lane & 31, h = lane >> 5;
  bf16x8 qf[NSTEP];
  {
    const bf16_t* qr = Q + (size_t)(q0 + wave * 32 + r) * DQK + 8 * h;
#pragma unroll
    for (int s = 0; s < NSTEP; ++s) qf[s] = *(const bf16x8*)(qr + 16 * s);
  }
  const int kid0 = tid, kid1 = tid + 256, kid2 = tid + 512;
  const int kgo0 = (kid0 / KCH) * DQK + (kid0 % KCH) * 8, kgo1 = (kid1 / KCH) * DQK + (kid1 % KCH) * 8, kgo2 = (kid2 / KCH) * DQK + (kid2 % KCH) * 8;
  const int kso0 = (kid0 / KCH) * KROW + (kid0 % KCH) * 8, kso1 = (kid1 / KCH) * KROW + (kid1 % KCH) * 8, kso2 = (kid2 / KCH) * KROW + (kid2 % KCH) * 8;
  const int vrow0 = tid >> 3, vcc = (tid & 7) * 8;
  const bf16_t* Vg0 = Vt + (size_t)vrow0 * NKEY + vcc;
  const bf16_t* Vg1 = Vt + (size_t)(vrow0 + 32) * NKEY + vcc;
  const int vso0 = vrow0 * VROW + vcc, vso1 = (vrow0 + 32) * VROW + vcc;
  uint4 pk0, pk1, pk2, pv0, pv1, qk0, qk1, qk2, qv0, qv1;
  pk2 = make_uint4(0, 0, 0, 0); qk2 = pk2;
#define A_LOAD(P, key0_)                                                        \
  {                                                                             \
    const bf16_t* kb_ = Kp + (size_t)(key0_) * DQK;                             \
    P##k0 = *(const uint4*)(kb_ + kgo0);                                        \
    P##k1 = *(const uint4*)(kb_ + kgo1);                                        \
    if (K3) P##k2 = *(const uint4*)(kb_ + kgo2);                                \
    P##v0 = *(const uint4*)(Vg0 + (key0_));                                     \
    P##v1 = *(const uint4*)(Vg1 + (key0_));                                     \
  }
#define A_WRITE(P, buf_)                                                        \
  {                                                                             \
    bf16_t* kw_ = sK + (buf_) * 64 * KROW;                                      \
    bf16_t* vw_ = sV + (buf_) * 64 * VROW;                                      \
    *(uint4*)(kw_ + kso0) = P##k0;                                              \
    *(uint4*)(kw_ + kso1) = P##k1;                                              \
    if (K3) *(uint4*)(kw_ + kso2) = P##k2;                                      \
    ((uint2*)(vw_ + vso0))[0] = make_uint2(P##v0.x, P##v0.y);                   \
    ((uint2*)(vw_ + vso0))[1] = make_uint2(P##v0.z, P##v0.w);                   \
    ((uint2*)(vw_ + vso1))[0] = make_uint2(P##v1.x, P##v1.y);                   \
    ((uint2*)(vw_ + vso1))[1] = make_uint2(P##v1.z, P##v1.w);                   \
  }
  f32x16 o0, o1;
#pragma unroll
  for (int i = 0; i < 16; ++i) { o0[i] = 0.f; o1[i] = 0.f; }
  float m = -1e30f, l = 0.f;
#define A_TILE(buf_)                                                            \
  {                                                                             \
    const bf16_t* kb = sK + (buf_) * 64 * KROW + r * KROW + 8 * h;              \
    f32x16 s0, s1;                                                              \
    _Pragma("unroll") for (int i = 0; i < 16; ++i) { s0[i] = 0.f; s1[i] = 0.f; } \
    __builtin_amdgcn_s_setprio(1);                                              \
    _Pragma("unroll") for (int s = 0; s < NSTEP; ++s) {                         \
      bf16x8 k0 = *(const bf16x8*)(kb + 16 * s);                                \
      bf16x8 k1 = *(const bf16x8*)(kb + 32 * KROW + 16 * s);                    \
      s0 = MFMA32(k0, qf[s], s0);                                               \
      s1 = MFMA32(k1, qf[s], s1);                                               \
    }                                                                           \
    __builtin_amdgcn_s_setprio(0);                                              \
    float mxa = fmaxf(s0[0], s1[0]), mxb = fmaxf(s0[1], s1[1]), mxc = fmaxf(s0[2], s1[2]), mxd = fmaxf(s0[3], s1[3]); \
    _Pragma("unroll") for (int i = 4; i < 16; i += 4) {                         \
      mxa = fmaxf(fmaxf(mxa, s0[i]), s1[i]); mxb = fmaxf(fmaxf(mxb, s0[i + 1]), s1[i + 1]); \
      mxc = fmaxf(fmaxf(mxc, s0[i + 2]), s1[i + 2]); mxd = fmaxf(fmaxf(mxd, s0[i + 3]), s1[i + 3]); \
    }                                                                           \
    float mx = fmaxf(fmaxf(mxa, mxb), fmaxf(mxc, mxd));                         \
    mx = xhalf_max(mx);                                                         \
    if (__builtin_amdgcn_ballot_w64(mx > m + 8.0f) != 0ull) {                   \
      const float mn = fmaxf(m, mx);                                            \
      const float alpha = __builtin_amdgcn_exp2f(m - mn);                       \
      m = mn;                                                                   \
      l *= alpha;                                                               \
      _Pragma("unroll") for (int i = 0; i < 16; ++i) { o0[i] *= alpha; o1[i] *= alpha; } \
    }                                                                           \
    float ls = 0.f;                                                             \
    _Pragma("unroll") for (int i = 0; i < 16; ++i) { s0[i] = __builtin_amdgcn_exp2f(s0[i] - m); ls += s0[i]; } \
    _Pragma("unroll") for (int i = 0; i < 16; ++i) { s1[i] = __builtin_amdgcn_exp2f(s1[i] - m); ls += s1[i]; } \
    l += ls;                                                                    \
    const bf16_t* vb = sV + (buf_) * 64 * VROW + r * VROW + 4 * h;              \
    __builtin_amdgcn_s_setprio(1);                                              \
    _Pragma("unroll") for (int t = 0; t < 2; ++t)                               \
      _Pragma("unroll") for (int s = 0; s < 2; ++s) {                           \
        bf16x8 pbv;                                                             \
        if (t == 0) pbv = pack8(s0[8 * s + 0], s0[8 * s + 1], s0[8 * s + 2], s0[8 * s + 3], s0[8 * s + 4], s0[8 * s + 5], s0[8 * s + 6], s0[8 * s + 7]); \
        else pbv = pack8(s1[8 * s + 0], s1[8 * s + 1], s1[8 * s + 2], s1[8 * s + 3], s1[8 * s + 4], s1[8 * s + 5], s1[8 * s + 6], s1[8 * s + 7]); \
        const int koff = 32 * t + 16 * s;                                       \
        const uint2 va0 = *(const uint2*)(vb + koff), va1 = *(const uint2*)(vb + koff + 8); \
        const uint2 vc0 = *(const uint2*)(vb + 32 * VROW + koff), vc1 = *(const uint2*)(vb + 32 * VROW + koff + 8); \
        const bf16x8 vav = __builtin_bit_cast(bf16x8, make_uint4(va0.x, va0.y, va1.x, va1.y)); \
        const bf16x8 vcv = __builtin_bit_cast(bf16x8, make_uint4(vc0.x, vc0.y, vc1.x, vc1.y)); \
        o0 = MFMA32(vav, pbv, o0);                                              \
        o1 = MFMA32(vcv, pbv, o1);                                              \
      }                                                                         \
    __builtin_amdgcn_s_setprio(0);                                              \
  }
  const int nt = nkeys >> 6;
  A_LOAD(p, 0)
  A_LOAD(q, 64)
  A_WRITE(p, 0)
  __syncthreads();
  if (nt > 2) A_LOAD(p, 128)
  for (int kt = 0; kt < nt; kt += 2) {
    A_TILE(0)
    A_WRITE(q, 1)
    __syncthreads();
    if (kt + 3 < nt) A_LOAD(q, (kt + 3) << 6)
    A_TILE(1)
    if (kt + 2 < nt) A_WRITE(p, 0)
    __syncthreads();
    if (kt + 4 < nt) A_LOAD(p, (kt + 4) << 6)
  }
#undef A_LOAD
#undef A_WRITE
#undef A_TILE
  l = xhalf_sum(l);
  const float inv = 1.0f / l;
  const int kp = q0 + wave * 32 + r;
  bf16_t* orow = mix + (size_t)row_of(b, kp) * D + colbase;
#pragma unroll
  for (int g = 0; g < 4; ++g) {
    uint2 w0, w1;
    w0.x = pack2(o0[4 * g] * inv, o0[4 * g + 1] * inv); w0.y = pack2(o0[4 * g + 2] * inv, o0[4 * g + 3] * inv);
    w1.x = pack2(o1[4 * g] * inv, o1[4 * g + 1] * inv); w1.y = pack2(o1[4 * g + 2] * inv, o1[4 * g + 3] * inv);
    *(uint2*)(orow + 8 * g + 4 * h) = w0;
    *(uint2*)(orow + 32 + 8 * g + 4 * h) = w1;
  }
}

DI void ytrans_loop(const Params& p, char* smem) {
  bf16_t* sT = (bf16_t*)smem;
  const int tid = get_tid();
  int it = blockIdx.x;
  if (it >= 2048) return;
  const int cc0 = tid >> 3, t8 = tid & 7;
  uint4 w0, w1, n0, n1;
#define YT_LOAD(it_, A0, A1)                                                                              \
  {                                                                                                       \
    const int b_ = (it_) >> 8, tt0_ = (((it_) >> 2) & 63) * 64, c0_ = ((it_) & 3) * 64;                   \
    const bf16_t* YT_ = (const bf16_t*)(p.ws + OFF_H + (4u << 20)) + ((size_t)b_ * 256 + c0_) * SEQ + tt0_; \
    A0 = *(const uint4*)(YT_ + (size_t)cc0 * SEQ + t8 * 8);                                               \
    A1 = *(const uint4*)(YT_ + (size_t)(cc0 + 32) * SEQ + t8 * 8);                                        \
  }
  YT_LOAD(it, w0, w1)
  for (;;) {
    const int itn = it + gridDim.x;
    const bool has = itn < 2048;
    if (has) YT_LOAD(itn, n0, n1)
    {
      const unsigned pa[4] = {w0.x, w0.y, w0.z, w0.w}, pb[4] = {w1.x, w1.y, w1.z, w1.w};
#pragma unroll
      for (int e = 0; e < 8; ++e) {
        sT[(t8 * 8 + e) * 66 + cc0] = (bf16_t)((pa[e >> 1] >> ((e & 1) * 16)) & 0xffff);
        sT[(t8 * 8 + e) * 66 + cc0 + 32] = (bf16_t)((pb[e >> 1] >> ((e & 1) * 16)) & 0xffff);
      }
    }
    __syncthreads();
    {
      const int b = it >> 8, tt0 = ((it >> 2) & 63) * 64, c0 = (it & 3) * 64;
      bf16_t* MIX = (bf16_t*)(p.ws + OFF_U) + ((size_t)b * SEQ + tt0) * D + c0;
#pragma unroll
      for (int i = 0; i < 2; ++i) {
        int id = tid + 256 * i, tt = id >> 3, c8 = id & 7;
        const unsigned* sp = (const unsigned*)(sT + tt * 66 + c8 * 8);
        uint4 w; w.x = sp[0]; w.y = sp[1]; w.z = sp[2]; w.w = sp[3];
        *(uint4*)(MIX + (size_t)tt * D + c8 * 8) = w;
      }
    }
    __syncthreads();
    if (!has) break;
    it = itn; w0 = n0; w1 = n1;
  }
#undef YT_LOAD
}

DI void attn_dispatch(const Params& p, int type, int b, int hd, int qb, char* smem) {
  bf16_t* MIX = (bf16_t*)(p.ws + OFF_U);
  const int nkeys = qb < 2 ? CTX : NKEY;
  if (type == 0) {
    const bf16_t* Q = (const bf16_t*)(p.ws + OFF_QG) + (size_t)(b * 6 + hd) * NKEY * 64;
    const bf16_t* K = (const bf16_t*)(p.ws + OFF_KG) + (size_t)(b * 2 + hd / 3) * NKEY * 64;
    const bf16_t* V = (const bf16_t*)(p.ws + OFF_VGT) + (size_t)(b * 2 + hd / 3) * 64 * NKEY;
    attn_item<64>(Q, K, V, qb * 128, nkeys, MIX, 256 + hd * 64, b, smem);
  } else {
    const bf16_t* Q = (const bf16_t*)(p.ws + OFF_QM) + (size_t)(b * 6 + hd) * NKEY * 96;
    const bf16_t* K = (const bf16_t*)(p.ws + OFF_KM) + (size_t)(b * 6 + hd) * NKEY * 96;
    const bf16_t* V = (const bf16_t*)(p.ws + OFF_VMT) + (size_t)(b * 6 + hd) * 64 * NKEY;
    attn_item<96>(Q, K, V, qb * 128, nkeys, MIX, 640 + hd * 64, b, smem);
  }
}

DI void phase_attn(const Params& p, int layer, char* smem) {
  const int n_lat = 96 * 32, n_ctx = (layer == 0) ? 96 * 2 : 0;
  for (int it = blockIdx.x; it < n_lat + n_ctx; it += gridDim.x) {
    int combo, qb;
    if (it < n_lat) { int xc = it & 7, j = it >> 3; combo = (j >> 5) * 8 + xc; qb = 2 + (j & 31); }
    else { int r = it - n_lat; combo = r >> 1; qb = r & 1; }
    const int type = combo / 48, bh = combo % 48;
    attn_dispatch(p, type, bh / 6, bh % 6, qb, smem);
  }
  ytrans_loop(p, smem);
  if (layer == 0) {
    const bf16_t* YC = (const bf16_t*)(p.ws + OFF_H);
    bf16_t* MIX = (bf16_t*)(p.ws + OFF_U);
    for (int i = blockIdx.x * 256 + get_tid(); i < NCTXR * 32; i += gridDim.x * 256) {
      int rr = i >> 5, c8 = i & 31;
      *(uint4*)(MIX + (size_t)(NLAT + rr) * D + c8 * 8) = *(const uint4*)(YC + (size_t)rr * 256 + c8 * 8);
    }
  }
}

DI void phase_mix_a(const Params& p, int layer, char* smem) {
  const bf16_t* wl = (const bf16_t*)(p.ws + OFF_W) + (size_t)layer * WL;
  for (int it = blockIdx.x; it < 512; it += gridDim.x) hyena_item(p, layer, it >> 1, it & 1, smem);
  if (layer == 0)
    for (int it = blockIdx.x; it < NB * 256; it += gridDim.x) hyena_ctx_item(p, layer, it >> 8, it & 255, smem);
  const int MT = NTOK / 128;
  gemm_phase<EPI_QUP>(p, layer, (const bf16_t*)(p.ws + OFF_MQN), 256, wl + W_UQ, 256, 256, (layer == 0) ? MT : NLAT / 128, 5, smem);
  gemm_phase<EPI_KVUP>(p, layer, (const bf16_t*)(p.ws + OFF_MKVN), 128, wl + W_UKV, 128, 128, MT, 6, smem, true);
}

#define XB_TMO      128
#define XB_XCNT(j)  (256  + 64 * (j))
#define XB_XSUB(j)  (1280 + 64 * (j))
#define XB_XGEN(j)  (2304 + 64 * (j))
#define XB_TOP      3328
#define XB_TOPGEN   3392
#define XCD_BAR_WORDS 3456
#define XB_SPIN_CAP (1u << 20)
#define LAS __attribute__((address_space(3)))
DI unsigned xb_ld(unsigned* p) { return __hip_atomic_load(p, __ATOMIC_RELAXED, __HIP_MEMORY_SCOPE_AGENT); }
DI unsigned xb_add(unsigned* p, unsigned v) { return __hip_atomic_fetch_add(p, v, __ATOMIC_RELAXED, __HIP_MEMORY_SCOPE_AGENT); }
DI unsigned xb_xcc_id() { return (unsigned)__builtin_amdgcn_s_getreg((3 << 11) | 20) & 0xFu; }
#define XB_SPIN(cond, bar) do { unsigned _sp = 0; while (cond) { __builtin_amdgcn_s_sleep(1); \
    if ((++_sp & 255u) == 0u) { if (xb_ld(&(bar)[XB_TMO])) break; if (_sp > XB_SPIN_CAP) { atomicAdd(&(bar)[XB_TMO], 1u); break; } } } } while (0)
struct XcdBarrier { unsigned* bar; unsigned x; volatile LAS unsigned* st; };
DI XcdBarrier xcd_barrier_post(unsigned* bar, volatile LAS unsigned* st) {
  XcdBarrier b; b.bar = bar; b.x = xb_xcc_id(); b.st = st;
  if (threadIdx.x == 0) (void)xb_add(&bar[XB_XCNT(b.x)], 1u);
  return b;
}
DI void xcd_barrier_complete(unsigned* bar, unsigned x, unsigned& nloc, unsigned& nx) {
  const unsigned G = gridDim.x * gridDim.y * gridDim.z;
  unsigned sum, cnt, mine, sp = 0u;
  for (;;) {
    sum = 0u; cnt = 0u; mine = 0u;
#pragma unroll
    for (unsigned j = 0; j < 16; ++j) { const unsigned c = xb_ld(&bar[XB_XCNT(j)]); sum += c; cnt += (c > 0u) ? 1u : 0u; mine = (j == x) ? c : mine; }
    if (sum == G) break;
    __builtin_amdgcn_s_sleep(1);
    if ((++sp & 255u) == 0u) { if (xb_ld(&bar[XB_TMO])) break; if (sp > XB_SPIN_CAP) { atomicAdd(&bar[XB_TMO], 1u); break; } }
  }
  nloc = mine > 0u ? mine : 1u; nx = cnt > 0u ? cnt : 1u;
}
DI void xcd_barrier(const XcdBarrier& b) {
  asm volatile("s_waitcnt vmcnt(0)" ::: "memory");
  __syncthreads();
  if (threadIdx.x == 0) {
    unsigned* bar = b.bar;
    __builtin_amdgcn_s_waitcnt(0);
    unsigned nloc = b.st[0], nx = b.st[1];
    if (nloc == 0u) { xcd_barrier_complete(bar, b.x, nloc, nx); b.st[0] = nloc; b.st[1] = nx; }
    const unsigned old = xb_add(&bar[XB_XSUB(b.x)], 1u);
    const unsigned gen = old / nloc;
    if (old + 1u == (gen + 1u) * nloc) {
      __builtin_amdgcn_fence(__ATOMIC_RELEASE, "agent");
      asm volatile("s_waitcnt vmcnt(0)" ::: "memory");
      const unsigned og = xb_add(&bar[XB_TOP], 1u);
      const unsigned tg = og / nx;
      if (og + 1u == (tg + 1u) * nx) xb_add(&bar[XB_TOPGEN], 1u);
      else XB_SPIN(xb_ld(&bar[XB_TOPGEN]) == tg, bar);
      __builtin_amdgcn_fence(__ATOMIC_ACQUIRE, "agent");
      xb_add(&bar[XB_XGEN(b.x)], 1u);
      asm volatile("s_waitcnt vmcnt(0)" ::: "memory");
    } else {
      XB_SPIN(xb_ld(&bar[XB_XGEN(b.x)]) == gen, bar);
      __builtin_amdgcn_fence(__ATOMIC_ACQUIRE, "agent");
      asm volatile("s_waitcnt vmcnt(0)" ::: "memory");
    }
  }
  __syncthreads();
}

DI void flat_barrier(unsigned* cnt, unsigned& gen) {
  asm volatile("s_waitcnt vmcnt(0)" ::: "memory");
  __syncthreads();
  if (threadIdx.x == 0) {
    __builtin_amdgcn_fence(__ATOMIC_RELEASE, "agent");
    asm volatile("s_waitcnt vmcnt(0)" ::: "memory");
    xb_add(cnt, 1u);
    const unsigned target = (gen + 1u) * gridDim.x;
    unsigned sp = 0;
    while (xb_ld(cnt) < target) { __builtin_amdgcn_s_sleep(1); if (++sp > (1u << 22)) break; }
    __builtin_amdgcn_fence(__ATOMIC_ACQUIRE, "agent");
    asm volatile("s_waitcnt vmcnt(0)" ::: "memory");
  }
  gen += 1u;
  __syncthreads();
}

__global__ void __launch_bounds__(THREADS, 2) fwd_megakernel(Params p) {
  __shared__ __attribute__((aligned(16))) char smem[79872];
  cg::grid_group grid = cg::this_grid();
  volatile LAS unsigned* xst = (volatile LAS unsigned*)(smem + 79856);
  if (threadIdx.x == 0) { xst[0] = 0u; xst[1] = 0u; }
  __syncthreads();
  if (p.ws == nullptr) grid.sync();
  const XcdBarrier xb = xcd_barrier_post((unsigned*)(p.ws + OFF_BAR), xst);
  phase_prologue(p, smem);
  xcd_barrier(xb);
  phase_modfinal(p);
  xcd_barrier(xb);
  for (int layer = 0; layer < 2; ++layer) {
    const bf16_t* wl = (const bf16_t*)(p.ws + OFF_W) + (size_t)layer * WL;
    const int MT_ALL = NTOK / 128, MT_LAT = NLAT / 128;
    const int MT_RES = (layer == 0) ? MT_ALL : MT_LAT;
    phase_norm(p, layer, 0, NTOK);
    xcd_barrier(xb);
    gemm_phase<EPI_U>(p, layer, (const bf16_t*)(p.ws + OFF_H), D, wl + W_IN, D, D, MT_ALL, INP / 128, smem);
    xcd_barrier(xb);
    phase_prep(p, layer, smem);
    xcd_barrier(xb);
    phase_mix_a(p, layer, smem);
    xcd_barrier(xb);
    phase_attn(p, layer, smem);
    xcd_barrier(xb);
    gemm_phase<EPI_RES1>(p, layer, (const bf16_t*)(p.ws + OFF_U), D, wl + W_OUT, D, D, MT_RES, D / 128, smem);
    xcd_barrier(xb);
    phase_norm(p, layer, 1, MT_RES * 128);
    xcd_barrier(xb);
    gemm_phase<EPI_SWIGLU>(p, layer, (const bf16_t*)(p.ws + OFF_H), D, wl + W_13, D, D, MT_RES, 2 * FFH / 128, smem);
    xcd_barrier(xb);
    gemm_phase<EPI_RES2>(p, layer, (const bf16_t*)(p.ws + OFF_U), FFH, wl + W_2, FFH, FFH, MT_RES, D / 128, smem);
    xcd_barrier(xb);
  }
  phase_final(p);
}

extern "C" void kernel_launch(void* const* d_in, const int* in_sizes, int n_in, void* d_out, int out_size, void* d_ws, size_t ws_size,
                              hipStream_t stream) {
  static int grid_blocks = 0;
  if (!grid_blocks) {
    int dev = 0, cus = 0, per_cu = 0;
    hipGetDevice(&dev);
    hipDeviceGetAttribute(&cus, hipDeviceAttributeMultiprocessorCount, dev);
    hipOccupancyMaxActiveBlocksPerMultiprocessor(&per_cu, fwd_megakernel, THREADS, 0);
    if (per_cu > 2) per_cu = 2;
    if (per_cu < 1) per_cu = 1;
    grid_blocks = cus * per_cu;
  }
  if (ws_size < WS_NEED) { fprintf(stderr, "workspace too small: %zu < %zu\n", ws_size, (size_t)WS_NEED); return; }
  Params p{};
  const float** f = (const float**)&p;
  for (int i = 0; i < 29; ++i) f[i] = (const float*)d_in[i];
  p.out = (float*)d_out;
  p.ws = (char*)d_ws;
  void* args[] = {&p};
  (void)hipMemsetAsync((char*)d_ws + OFF_BAR, 0, XCD_BAR_WORDS * 4, stream);
  hipError_t e = hipLaunchCooperativeKernel((void*)fwd_megakernel, dim3(grid_blocks), dim3(THREADS), args, 0, stream);
  if (e != hipSuccess) fprintf(stderr, "cooperative launch failed: %s (grid %d)\n", hipGetErrorString(e), grid_blocks);
}
#ifdef PHASE_TEST
#define TK(name, body) __global__ void __launch_bounds__(THREADS, 2) name(Params p) { __shared__ __attribute__((aligned(16))) char smem[79872]; body; }
TK(t_prologue, phase_prologue(p, smem))
TK(t_norm, phase_norm(p, 1, 0, NTOK))
TK(t_gemm_u, gemm_phase<EPI_U>(p, 1, (const bf16_t*)(p.ws + OFF_H), D, (const bf16_t*)(p.ws + OFF_W), D, D, 272, 15, smem))
TK(t_gemm_res1, gemm_phase<EPI_RES1>(p, 1, (const bf16_t*)(p.ws + OFF_H), D, (const bf16_t*)(p.ws + OFF_W), D, D, 272, 8, smem))
TK(t_gemm_swiglu, gemm_phase<EPI_SWIGLU>(p, 1, (const bf16_t*)(p.ws + OFF_H), D, (const bf16_t*)(p.ws + OFF_W), D, D, 272, 44, smem))
TK(t_gemm_qup, gemm_phase<EPI_QUP>(p, 1, (const bf16_t*)(p.ws + OFF_H), 256, (const bf16_t*)(p.ws + OFF_W), 256, 256, 272, 5, smem))
TK(t_gemm_kvup, gemm_phase<EPI_KVUP>(p, 1, (const bf16_t*)(p.ws + OFF_H), 128, (const bf16_t*)(p.ws + OFF_W), 128, 128, 272, 6, smem))
TK(t_prep, phase_prep(p, 1, smem))
TK(t_hyena, hyena_item(p, 1, blockIdx.x >> 1, blockIdx.x & 1, smem))
TK(t_hyena_ctx, hyena_ctx_item(p, 0, blockIdx.x >> 8, blockIdx.x & 255, smem))
TK(t_attn, phase_attn(p, 0, smem))
TK(t_final, phase_final(p))
#endif
```
